# Optimizing an MI355X kernel written in HIP

```python
import math
import jax, jax.numpy as jnp
from jax import lax
import numpy as np

D_MODEL = 1024
BATCH = 4
SEQ = 8192
DEPTH = 4

N_MIXERS = 3
D_FF = 2816
N_SUB = 3
EPS = 1e-6
A_HEADS = 8
A_DK = D_MODEL // A_HEADS
A_DV = D_MODEL // A_HEADS
A_CHUNK = 64
B_HEADS = 8
B_DH = D_MODEL // (2 * B_HEADS)
B_ROT = B_DH // 4
ROPE_THETA = 500000.0
Q_BLOCK = 128
C_WIDTH = 3
N_A = (DEPTH + 2) // N_MIXERS
N_B = (DEPTH + 1) // N_MIXERS
N_C = DEPTH // N_MIXERS

kernel_name = "hybrid_hgrn2_diffattn_shortconv_macaron"


def rmsnorm(x, g):
    xf = x.astype(jnp.float32)
    y = xf * lax.rsqrt(jnp.mean(xf * xf, axis=-1, keepdims=True) + EPS)
    return (y * g.astype(jnp.float32)).astype(x.dtype)


def swiglu(h, wi, wo):
    gt, up = jnp.split(h @ wi, 2, axis=-1)
    return (jax.nn.silu(gt) * up) @ wo


def partial_rope(x, cos, sin):
    xr, xp = x[..., :B_ROT], x[..., B_ROT:]
    x1 = xr[..., :B_ROT // 2].astype(jnp.float32)
    x2 = xr[..., B_ROT // 2:].astype(jnp.float32)
    rot = jnp.concatenate([x1 * cos - x2 * sin, x2 * cos + x1 * sin], axis=-1)
    return jnp.concatenate([rot.astype(x.dtype), xp], axis=-1)


def hgrn2_mixer(h, w_in, w_out, lb, onorm_g):
    Bn, S, _ = h.shape
    nc = S // A_CHUNK
    q, fz, i, g = jnp.split(h @ w_in, 4, axis=-1)
    q = jax.nn.silu(q).astype(jnp.float32)
    f = lb.astype(jnp.float32) + (1.0 - lb.astype(jnp.float32)) * jax.nn.sigmoid(fz.astype(jnp.float32))
    logf = jnp.log(f)
    k = 1.0 - f

    def heads(t, dh):
        t = t.astype(jnp.float32).reshape(Bn, nc, A_CHUNK, A_HEADS, dh)
        return t.transpose(1, 0, 3, 2, 4)

    causal = jnp.tril(jnp.ones((A_CHUNK, A_CHUNK), dtype=bool))

    def step(state, inp):
        q_c, k_c, v_c, lf_c = inp
        b = jnp.cumsum(lf_c, axis=2)
        inter = jnp.einsum('bhtk,bhkv->bhtv', q_c * jnp.exp(b), state)
        diff = b[:, :, :, None, :] - b[:, :, None, :, :]
        decay = jnp.exp(jnp.where(causal[:, :, None], diff, -jnp.inf))
        att = jnp.einsum('bhtk,bhsk,bhtsk->bhts', q_c, k_c, decay)
        intra = jnp.einsum('bhts,bhsv->bhtv', att, v_c)
        b_last = b[:, :, -1]
        new_state = jnp.exp(b_last)[..., None] * state + jnp.einsum(
            'bhsk,bhsv->bhkv', k_c * jnp.exp(b_last[:, :, None] - b), v_c)
        return new_state, inter + intra

    s0 = jnp.zeros((Bn, A_HEADS, A_DK, A_DV), jnp.float32)
    _, o = lax.scan(step, s0, (heads(q, A_DK), heads(k, A_DK), heads(i, A_DV), heads(logf, A_DK)))
    o = o.transpose(1, 0, 3, 2, 4).reshape(Bn, S, A_HEADS, A_DV)
    o = rmsnorm(o, onorm_g) * jax.nn.silu(g.astype(jnp.float32).reshape(Bn, S, A_HEADS, A_DV))
    return o.reshape(Bn, S, D_MODEL).astype(h.dtype) @ w_out


def diff_attention_mixer(h, w_in, w_out, qk_g, lam_p, subln_g, cos, sin, lambda_init):
    Bn, S, _ = h.shape
    q, k, v = jnp.split(h @ w_in, 3, axis=-1)
    q = q.reshape(Bn, S, B_HEADS, 2, B_DH)
    k = k.reshape(Bn, S, B_HEADS, 2, B_DH)
    v = v.reshape(Bn, S, B_HEADS, 2 * B_DH).transpose(0, 2, 1, 3)
    q = partial_rope(rmsnorm(q, qk_g[0]), cos, sin).transpose(0, 2, 3, 1, 4)
    k = partial_rope(rmsnorm(k, qk_g[1]), cos, sin).transpose(0, 2, 3, 1, 4)
    lp = lam_p.astype(jnp.float32)
    lam = jnp.exp(jnp.sum(lp[0] * lp[1])) - jnp.exp(jnp.sum(lp[2] * lp[3])) + lambda_init
    scale = B_DH ** -0.5
    outs = []
    for blk in range(S // Q_BLOCK):
        s0 = blk * Q_BLOCK
        s1 = s0 + Q_BLOCK
        sc = jnp.einsum('bhcqd,bhckd->bhcqk', q[:, :, :, s0:s1], k[:, :, :, :s1]).astype(jnp.float32) * scale
        mask = (s0 + jnp.arange(Q_BLOCK))[:, None] >= jnp.arange(s1)[None, :]
        p = jax.nn.softmax(jnp.where(mask, sc, -jnp.inf), axis=-1)
        a = p[:, :, 0] - lam * p[:, :, 1]
        outs.append(jnp.einsum('bhqk,bhkv->bhqv', a.astype(v.dtype), v[:, :, :s1]))
    o = jnp.concatenate(outs, axis=2)
    o = rmsnorm(o, subln_g) * (1.0 - lambda_init)
    return o.transpose(0, 2, 1, 3).reshape(Bn, S, D_MODEL) @ w_out


def short_conv_mixer(h, w_in, conv_w, w_out):
    bg, cg, u = jnp.split(h @ w_in, 3, axis=-1)
    u = cg * u
    up = jnp.pad(u, ((0, 0), (C_WIDTH - 1, 0), (0, 0)))
    y = conv_w[0] * up[:, :-2] + conv_w[1] * up[:, 1:-1] + conv_w[2] * up[:, 2:]
    return (bg * y) @ w_out


def setup_inputs(seed: int = 0) -> dict:
    key = jax.random.key(seed)
    ks = jax.random.split(key, 24)
    D, F = D_MODEL, D_FF
    sD, sF = D ** -0.5, F ** -0.5
    n = jax.random.normal
    return {
        "x": n(ks[0], (BATCH, SEQ, D), jnp.float32),
        "c": n(ks[1], (BATCH, D), jnp.float32),
        "positions": (jnp.arange(SEQ, dtype=jnp.int32)[None, :]
                      + jax.random.randint(ks[2], (BATCH, 1), 0, 4096, dtype=jnp.int32)),
        "ada_w": n(ks[3], (DEPTH, D, 3 * N_SUB * D), jnp.float32) * (0.2 * sD),
        "ada_b": n(ks[4], (DEPTH, 3 * N_SUB * D), jnp.float32) * 0.02,
        "norm_g": 1.0 + 0.02 * n(ks[5], (DEPTH, N_SUB, D), jnp.float32),
        "ffn_wi": n(ks[6], (DEPTH, 2, D, 2 * F), jnp.float32) * sD,
        "ffn_wo": n(ks[7], (DEPTH, 2, F, D), jnp.float32) * sF,
        "a_w_in": n(ks[8], (N_A, D, 4 * D), jnp.float32) * sD,
        "a_w_out": n(ks[9], (N_A, D, D), jnp.float32) * sD,
        "a_lb": 0.5 * n(ks[10], (N_A, D), jnp.float32),
        "a_onorm": 1.0 + 0.02 * n(ks[11], (N_A, A_DV), jnp.float32),
        "b_w_in": n(ks[12], (N_B, D, 3 * D), jnp.float32) * sD,
        "b_w_out": n(ks[13], (N_B, D, D), jnp.float32) * sD,
        "b_qk_g": 1.0 + 0.02 * n(ks[14], (N_B, 2, B_DH), jnp.float32),
        "b_lam": 0.1 * n(ks[15], (N_B, 4, B_DH), jnp.float32),
        "b_subln": 1.0 + 0.02 * n(ks[16], (N_B, 2 * B_DH), jnp.float32),
        "c_w_in": n(ks[17], (N_C, D, 3 * D), jnp.float32) * sD,
        "c_conv": n(ks[18], (N_C, C_WIDTH, D), jnp.float32) * (C_WIDTH ** -0.5),
        "c_w_out": n(ks[19], (N_C, D, D), jnp.float32) * sD,
    }


def reference(x, c, positions, ada_w, ada_b, norm_g, ffn_wi, ffn_wo,
              a_w_in, a_w_out, a_lb, a_onorm,
              b_w_in, b_w_out, b_qk_g, b_lam, b_subln,
              c_w_in, c_conv, c_w_out):
    Bn, S, D = x.shape
    inv_freq = ROPE_THETA ** (-jnp.arange(0, B_ROT, 2, dtype=jnp.float32) / B_ROT)
    ang = positions.astype(jnp.float32)[..., None] * inv_freq
    cos = jnp.cos(ang)[:, :, None, None, :]
    sin = jnp.sin(ang)[:, :, None, None, :]
    lb_sm = jax.nn.softmax(a_lb.astype(jnp.float32), axis=0)
    lb_all = jnp.cumsum(lb_sm, axis=0) - lb_sm[0]
    c_act = jax.nn.silu(c)

    for l in range(DEPTH):
        mod = (c_act @ ada_w[l] + ada_b[l]).reshape(Bn, N_SUB, 3, 1, D)

        def pre(h, j):
            return rmsnorm(h, norm_g[l, j]) * (1.0 + mod[:, j, 1]) + mod[:, j, 0]

        x = x + 0.5 * (1.0 + mod[:, 0, 2]) * swiglu(pre(x, 0), ffn_wi[l, 0], ffn_wo[l, 0])
        h = pre(x, 1)
        kind, idx = l % N_MIXERS, l // N_MIXERS
        if kind == 0:
            y = hgrn2_mixer(h, a_w_in[idx], a_w_out[idx], lb_all[idx], a_onorm[idx])
        elif kind == 1:
            lambda_init = 0.8 - 0.6 * math.exp(-0.3 * l)
            y = diff_attention_mixer(h, b_w_in[idx], b_w_out[idx], b_qk_g[idx], b_lam[idx],
                                     b_subln[idx], cos, sin, lambda_init)
        else:
            y = short_conv_mixer(h, c_w_in[idx], c_conv[idx], c_w_out[idx])
        x = x + (1.0 + mod[:, 1, 2]) * y
        x = x + 0.5 * (1.0 + mod[:, 2, 2]) * swiglu(pre(x, 2), ffn_wi[l, 1], ffn_wo[l, 1])
    return x
```

```cpp
#include <hip/hip_runtime.h>
#include <hip/hip_cooperative_groups.h>
#include <cstdio>
#include <cstdint>
__device__ __forceinline__ int opaque_tid() { int t = (int)threadIdx.x; asm volatile("" : "+v"(t)); return t; }
__device__ __forceinline__ int opaque_i(int v) { asm volatile("" : "+s"(v)); return v; }
namespace pg8 {
#define PG8_LAS __attribute__((address_space(3)))
typedef unsigned short bf16_t;
typedef short bf16x8 __attribute__((ext_vector_type(8)));
typedef float f32x4 __attribute__((ext_vector_type(4)));
typedef unsigned u32x4 __attribute__((ext_vector_type(4)));
constexpr int BM = 256, BK = 64, HALF = 128, HTB = HALF * BK * 2  , STAGE_BYTES = 8 * HTB, NXCD = 8, WGM = 8;

__host__ __device__ __forceinline__ int lds_byte(int r, int c) { const int st = (r >> 4) * 2 + (c >> 5), rr = r & 15, cc = c & 31, ob = rr * 64 + cc * 2; return st * 1024 + (ob ^ (((ob >> 9) & 1) << 5)); }
__host__ __device__ __forceinline__ void stage_rc(int b, int& R, int& C) { const int st = b / 1024, sb = b % 1024, swz = sb ^ (((sb >> 9) & 1) << 5); R = (st >> 1) * 16 + swz / 64; C = (st & 1) * 32 + (swz % 64) / 2; }
__host__ __device__ __forceinline__ int perm32(int rho) { const int n = rho >> 4, i = rho & 15; return 8 * (i >> 2) + 4 * n + (i & 3); }

struct Unit { int pm, pn, ui; };
struct Gemm { const bf16_t* A; const bf16_t* Bt; int M, N, K; };

struct StaticOrder {
    int nM, nN, nwg, G, c;
    __host__ __device__ void init(int M, int N, int G_, int c_) { nM = M / BM; nN = N / BM; nwg = nM * nN; G = G_; c = c_; }
    __host__ __device__ bool next(int i, Unit& u) const {
        const long L = (long)i * G + c; if (L >= nwg) return false;
        int wgid = (int)L; { const int q = nwg / NXCD, r = nwg % NXCD, xcd = wgid % NXCD, off = wgid / NXCD; wgid = (xcd < r ? xcd * (q + 1) : r * (q + 1) + (xcd - r) * q) + off; }
        const int nig = WGM * nN, gid = wgid / nig, fm = gid * WGM, gsz = (nM - fm) < WGM ? (nM - fm) : WGM;
        u.pm = fm + ((wgid % nig) % gsz); u.pn = (wgid % nig) / gsz; u.ui = i; return true;
    }
    __device__ __forceinline__ void a_ready(const Unit&) const {}
    __device__ __forceinline__ void done(const Unit&) const {}
};

typedef float f32x2c_t __attribute__((ext_vector_type(2))); typedef __bf16 bf16x2c_t __attribute__((ext_vector_type(2)));
__device__ __forceinline__ unsigned cvt_pk_bf16(float lo, float hi) { f32x2c_t v = {lo, hi}; bf16x2c_t b = __builtin_convertvector(v, bf16x2c_t); return __builtin_bit_cast(unsigned, b); }
typedef float f32x2 __attribute__((ext_vector_type(2)));
constexpr float RMS_EPS = 1e-6f;
constexpr float LOG2E = 1.4426950408889634f;
__device__ __forceinline__ float sigmoid_f(float v) { return __builtin_amdgcn_rcpf(1.0f + __builtin_amdgcn_exp2f(-LOG2E * v)); }
__device__ __forceinline__ float silu_f(float v) { return v * sigmoid_f(v); }
__device__ __forceinline__ u32x4 pack8(f32x4 a, f32x4 b) { u32x4 w; w.x = cvt_pk_bf16(a[0], a[1]); w.y = cvt_pk_bf16(a[2], a[3]); w.z = cvt_pk_bf16(b[0], b[1]); w.w = cvt_pk_bf16(b[2], b[3]); return w; }
__device__ __forceinline__ float row_rstd(const float* ssq, int row) {
    const f32x4* p = (const f32x4*)(ssq + (size_t)row * 16); const f32x4 a = p[0], b = p[1], c = p[2], d = p[3];
    const float s = (((a[0] + a[1]) + (a[2] + a[3])) + ((b[0] + b[1]) + (b[2] + b[3]))) + (((c[0] + c[1]) + (c[2] + c[3])) + ((d[0] + d[1]) + (d[2] + d[3])));
    return __builtin_amdgcn_rsqf(s * (1.0f / 1024.0f) + RMS_EPS); }
__device__ __forceinline__ void row_rstd4(const float* ssq, int row0, int fq, float (&rs)[4]) {
    f32x4 p[4];
#pragma unroll
    for (int m = 0; m < 4; ++m) p[m] = *(const f32x4*)(ssq + (size_t)(row0 + m * 16) * 16 + 4 * fq);
#pragma unroll
    for (int m = 0; m < 4; ++m) { float t = (p[m][0] + p[m][1]) + (p[m][2] + p[m][3]); t += __shfl_xor(t, 16); t += __shfl_xor(t, 32); rs[m] = __builtin_amdgcn_rsqf(t * (1.0f / 1024.0f) + RMS_EPS); }
}
__device__ __forceinline__ void row_rstd8(const float* ssq, int row0, int fq, float (&rs)[2][4]) {
    f32x4 p[2][4];
#pragma unroll
    for (int ai = 0; ai < 2; ++ai)
#pragma unroll
        for (int m = 0; m < 4; ++m) p[ai][m] = *(const f32x4*)(ssq + (unsigned)((row0 + ai * 128 + m * 16) * 16 + 4 * fq));
#pragma unroll
    for (int ai = 0; ai < 2; ++ai)
#pragma unroll
        for (int m = 0; m < 4; ++m) { float t = (p[ai][m][0] + p[ai][m][1]) + (p[ai][m][2] + p[ai][m][3]); t += __shfl_xor(t, 16); t += __shfl_xor(t, 32); rs[ai][m] = __builtin_amdgcn_rsqf(t * (1.0f / 1024.0f) + RMS_EPS); }
}
constexpr int BIAS_LD = 5632;

constexpr int EPI_LDS_OFF = 131072 + 256, EPI_UNIT_FLOATS = 512, EPI_MAX_UNITS = 11;
struct EpiSwiGLU {
    static constexpr bool PERM = true, AFTER_DRAIN = false;
    bf16_t* H; PG8_LAS const float* el;
    __device__ __forceinline__ void operator()(const f32x4 (&acc)[2][2][4][2], const Unit& u, int wr, int wc, int fr, int fq) const {
        const int hcol = u.pn * 128 + wc * 32 + 8 * fq;
        PG8_LAS const float* eu = el + u.ui * EPI_UNIT_FLOATS;
        PG8_LAS const float* bp = eu + 256 + wc * 32 + 8 * fq;
        const f32x4 bg0 = *(PG8_LAS const f32x4*)(bp), bg1 = *(PG8_LAS const f32x4*)(bp + 4), bu0 = *(PG8_LAS const f32x4*)(bp + 128), bu1 = *(PG8_LAS const f32x4*)(bp + 132);
#pragma unroll
        for (int ai = 0; ai < 2; ++ai) {
#pragma unroll
            for (int m = 0; m < 4; ++m) {
                const int rl = ai * 128 + wr * 64 + m * 16 + fr, row = u.pm * 256 + rl; const float rs = eu[rl];
                const f32x4 g0 = acc[ai][0][m][0] * rs + bg0, g1 = acc[ai][0][m][1] * rs + bg1, u0 = acc[ai][1][m][0] * rs + bu0, u1 = acc[ai][1][m][1] * rs + bu1;
                f32x4 h0, h1;
#pragma unroll
                for (int i = 0; i < 4; ++i) { const float ea = 1.0f + __builtin_amdgcn_exp2f(fminf(-LOG2E * g0[i], 60.0f)), eb = 1.0f + __builtin_amdgcn_exp2f(fminf(-LOG2E * g1[i], 60.0f));
                    const float r = __builtin_amdgcn_rcpf(ea * eb); h0[i] = g0[i] * (r * eb) * u0[i]; h1[i] = g1[i] * (r * ea) * u1[i]; }
                *(u32x4*)(H + (unsigned)(row * 2816 + hcol)) = pack8(h0, h1);
            } }
    }
};
template <class Sched> __device__ __forceinline__ void stage_swiglu(PG8_LAS float* el, const Sched& S, const float* ssq, const float* bias, int wave, int lane) {
    for (int i = wave; i < EPI_MAX_UNITS; i += 8) { Unit u; if (!S.next(i, u)) break;
        f32x4 p[4][4];
#pragma unroll
        for (int r = 0; r < 4; ++r)
#pragma unroll
            for (int q = 0; q < 4; ++q) p[r][q] = *(const f32x4*)(ssq + (unsigned)((u.pm * 256 + lane + 64 * r) * 16 + 4 * q));
        const f32x4 bv = *(const f32x4*)(bias + (u.pm >> 5) * BIAS_LD + u.pn * 256 + 4 * lane);
#pragma unroll
        for (int r = 0; r < 4; ++r) { float t[4];
#pragma unroll
            for (int q = 0; q < 4; ++q) t[q] = (p[r][q][0] + p[r][q][1]) + (p[r][q][2] + p[r][q][3]);
            el[i * EPI_UNIT_FLOATS + lane + 64 * r] = __builtin_amdgcn_rsqf(((t[0] + t[1]) + (t[2] + t[3])) * (1.0f / 1024.0f) + RMS_EPS); }
        *(PG8_LAS f32x4*)(el + i * EPI_UNIT_FLOATS + 256 + 4 * lane) = bv; }
}

struct EpiRes {
    static constexpr bool PERM = true, AFTER_DRAIN = false;
    const float* xin; float* xout; bf16_t* xg; float* ssqn; const float* gatep; const float* ngc; const float* scc; const float* ngn; const float* scn; float coef; int mode;
    __device__ __forceinline__ void operator()(f32x4 (&acc)[2][2][4][2], const Unit& u, int wr, int wc, int fr, int fq) const {
        const int b = u.pm >> 5, col0 = u.pn * 256 + wc * 32 + 8 * fq;
        f32x4 gs[2][2], rg[2][2];
#pragma unroll
        for (int bj = 0; bj < 2; ++bj)
#pragma unroll
            for (int n = 0; n < 2; ++n) { const int c = col0 + 128 * bj + 4 * n;
                { const f32x4 gt = (*(const f32x4*)(gatep + b * 9216 + c) + 1.0f) * coef;
#pragma unroll
                  for (int ai = 0; ai < 2; ++ai)
#pragma unroll
                      for (int m = 0; m < 4; ++m) acc[ai][bj][m][n] = acc[ai][bj][m][n] * gt; }
                gs[bj][n] = *(const f32x4*)(ngn + c) * (*(const f32x4*)(scn + b * 9216 + c) + 1.0f);
                const f32x4 gc = *(const f32x4*)(ngc + c) * (*(const f32x4*)(scc + b * 9216 + c) + 1.0f);
#pragma unroll
                for (int i = 0; i < 4; ++i) rg[bj][n][i] = 1.0f / gc[i]; }
#pragma unroll
        for (int am = 0; am < 4; ++am) { const int ai = am >> 1;
            u32x4 xr[2][2];
            if (mode != 0) {
#pragma unroll
                for (int mm = 0; mm < 2; ++mm)
#pragma unroll
                    for (int bj = 0; bj < 2; ++bj) xr[mm][bj] = *(const u32x4*)(xg + (unsigned)((u.pm * 256 + ai * 128 + wr * 64 + ((am & 1) * 2 + mm) * 16 + fr) * 1024 + col0 + 128 * bj));
            }
#pragma unroll
            for (int mm = 0; mm < 2; ++mm) { const int m = (am & 1) * 2 + mm;
                const int row = u.pm * 256 + ai * 128 + wr * 64 + m * 16 + fr; float ss = 0.f;
#pragma unroll
                for (int bj = 0; bj < 2; ++bj) { const unsigned off = (unsigned)(row * 1024 + col0 + 128 * bj);
                    f32x4 x0, x1;
                    if (mode == 0) { x0 = *(const f32x4*)(xin + off); x1 = *(const f32x4*)(xin + off + 4); }
                    else { const u32x4 w = xr[mm][bj];
                        x0 = (f32x4){__uint_as_float(w.x << 16), __uint_as_float(w.x & 0xffff0000u), __uint_as_float(w.y << 16), __uint_as_float(w.y & 0xffff0000u)} * rg[bj][0];
                        x1 = (f32x4){__uint_as_float(w.z << 16), __uint_as_float(w.z & 0xffff0000u), __uint_as_float(w.w << 16), __uint_as_float(w.w & 0xffff0000u)} * rg[bj][1]; }
                    x0 = x0 + acc[ai][bj][m][0]; x1 = x1 + acc[ai][bj][m][1];
                    if (mode == 2) { __builtin_nontemporal_store(x0, (f32x4*)(xout + off)); __builtin_nontemporal_store(x1, (f32x4*)(xout + off + 4)); }
                    else { ss += (x0[0] * x0[0] + x0[1] * x0[1]) + (x0[2] * x0[2] + x0[3] * x0[3]) + (x1[0] * x1[0] + x1[1] * x1[1]) + (x1[2] * x1[2] + x1[3] * x1[3]);
                        *(u32x4*)(xg + off) = pack8(x0 * gs[bj][0], x1 * gs[bj][1]); } }
                if (mode != 2) { ss += __shfl_xor(ss, 16); ss += __shfl_xor(ss, 32); if (fq == 0) ssqn[(unsigned)(row * 16 + u.pn * 4 + wc)] = ss; }
            }
        }
    }
};

struct EpiHgrnIn {
    static constexpr bool PERM = true, AFTER_DRAIN = false;
    bf16_t* QVG; float* LOGF; const float* ssq; const float* bias; const float* a_lb; int idx;
    __device__ __forceinline__ void operator()(const f32x4 (&acc)[2][2][4][2], const Unit& u, int wr, int wc, int fr, int fq) const {
        float rsv8[2][4]; row_rstd8(ssq, u.pm * 256 + wr * 64 + fr, fq, rsv8);
        const int b = u.pm >> 5, type = u.pn >> 2, bcol = u.pn * 256 + wc * 32 + 8 * fq, cc = (u.pn & 3) * 256 + wc * 32 + 8 * fq;
        f32x4 bv[2][2], lb[2][2];
#pragma unroll
        for (int bj = 0; bj < 2; ++bj)
#pragma unroll
            for (int n = 0; n < 2; ++n) { bv[bj][n] = *(const f32x4*)(bias + b * BIAS_LD + bcol + 128 * bj + 4 * n); lb[bj][n] = (f32x4){0.f, 0.f, 0.f, 0.f};
                if (type == 1 && idx != 0) { const f32x4 a0 = *(const f32x4*)(a_lb + cc + 128 * bj + 4 * n), a1 = *(const f32x4*)(a_lb + 1024 + cc + 128 * bj + 4 * n);
#pragma unroll
                    for (int i = 0; i < 4; ++i) lb[bj][n][i] = sigmoid_f(a1[i] - a0[i]); } }
#pragma unroll
        for (int ai = 0; ai < 2; ++ai) {
#pragma unroll
            for (int m = 0; m < 4; ++m) {
                const int row = u.pm * 256 + ai * 128 + wr * 64 + m * 16 + fr; const float rs = rsv8[ai][m];
#pragma unroll
                for (int bj = 0; bj < 2; ++bj) { const size_t off = (size_t)row * 1024 + cc + 128 * bj;
                    f32x4 v0 = acc[ai][bj][m][0] * rs + bv[bj][0], v1 = acc[ai][bj][m][1] * rs + bv[bj][1];
                    if (type == 1) {
#pragma unroll
                        for (int i = 0; i < 4; ++i) { const float f0 = fmaxf(lb[bj][0][i] + (1.0f - lb[bj][0][i]) * sigmoid_f(v0[i]), 1e-30f), f1 = fmaxf(lb[bj][1][i] + (1.0f - lb[bj][1][i]) * sigmoid_f(v1[i]), 1e-30f);
                            v0[i] = __logf(f0); v1[i] = __logf(f1); }
                        *(f32x4*)(LOGF + off) = v0; *(f32x4*)(LOGF + off + 4) = v1;
                    } else {
                        if (type != 2) {
#pragma unroll
                            for (int i = 0; i < 4; ++i) { v0[i] = silu_f(v0[i]); v1[i] = silu_f(v1[i]); } }
                        bf16_t* dst = QVG + (size_t)(type == 0 ? 0 : (type == 2 ? 1 : 2)) * 33554432u;
                        *(u32x4*)(dst + off) = pack8(v0, v1);
                    } }
            } }
    }
};

struct EpiAttnIn {
    static constexpr bool PERM = true, AFTER_DRAIN = false;
    bf16_t* QKV; const float* ssq; const float* bias; const float* qkg; const float* rope;
    __device__ __forceinline__ void operator()(const f32x4 (&acc)[2][2][4][2], const Unit& u, int wr, int wc, int fr, int fq) const {
        const int b = u.pm >> 5, bcol = u.pn * 256 + wc * 32 + 8 * fq;
        f32x4 bv[2][2];
#pragma unroll
        for (int bj = 0; bj < 2; ++bj)
#pragma unroll
            for (int n = 0; n < 2; ++n) bv[bj][n] = *(const f32x4*)(bias + b * BIAS_LD + bcol + 128 * bj + 4 * n);
        if (u.pn >= 8) {
#pragma unroll
            for (int ai = 0; ai < 2; ++ai) { float rsv[4]; row_rstd4(ssq, u.pm * 256 + ai * 128 + wr * 64 + fr, fq, rsv);
#pragma unroll
                for (int m = 0; m < 4; ++m) { const int row = u.pm * 256 + ai * 128 + wr * 64 + m * 16 + fr; const float rs = rsv[m];
#pragma unroll
                    for (int bj = 0; bj < 2; ++bj) *(u32x4*)(QKV + (size_t)67108864u + (size_t)row * 1024 + (u.pn - 8) * 256 + 128 * bj + wc * 32 + 8 * fq) = pack8(acc[ai][bj][m][0] * rs + bv[bj][0], acc[ai][bj][m][1] * rs + bv[bj][1]); } }
        } else {
            const int which = u.pn >> 2, gidx = (u.pn & 3) * 4 + wc; bf16_t* dst = QKV + (size_t)which * 33554432u; const float osc = which ? 1.0f : 0.125f * LOG2E;
            f32x4 gv[2][2];
#pragma unroll
            for (int bj = 0; bj < 2; ++bj)
#pragma unroll
                for (int n = 0; n < 2; ++n) gv[bj][n] = *(const f32x4*)(qkg + which * 64 + 32 * bj + 8 * fq + 4 * n);
#pragma unroll
            for (int ai = 0; ai < 2; ++ai) { float rsv[4]; row_rstd4(ssq, u.pm * 256 + ai * 128 + wr * 64 + fr, fq, rsv);
#pragma unroll
                for (int m = 0; m < 4; ++m) { const int row = u.pm * 256 + ai * 128 + wr * 64 + m * 16 + fr; const float rs = rsv[m];
                    f32x4 y[2][2]; float ss = 0.f;
#pragma unroll
                    for (int bj = 0; bj < 2; ++bj)
#pragma unroll
                        for (int n = 0; n < 2; ++n) { y[bj][n] = acc[ai][bj][m][n] * rs + bv[bj][n]; const f32x4 t = y[bj][n]; ss += (t[0] * t[0] + t[1] * t[1]) + (t[2] * t[2] + t[3] * t[3]); }
                    ss += __shfl_xor(ss, 16); ss += __shfl_xor(ss, 32);
                    const float r = __builtin_amdgcn_rsqf(ss * (1.0f / 64.0f) + RMS_EPS);
#pragma unroll
                    for (int bj = 0; bj < 2; ++bj)
#pragma unroll
                        for (int n = 0; n < 2; ++n) y[bj][n] = y[bj][n] * r * gv[bj][n];
                    const float* rp = rope + (size_t)row * 16;
#pragma unroll
                    for (int n = 0; n < 2; ++n) { const f32x4 cn = *(const f32x4*)(rp + 4 * n), sn = *(const f32x4*)(rp + 8 + 4 * n); f32x4 pn;
#pragma unroll
                        for (int i = 0; i < 4; ++i) pn[i] = __shfl_xor(y[0][n][i], 16);
                        if (fq == 0) y[0][n] = y[0][n] * cn - pn * sn; else if (fq == 1) y[0][n] = y[0][n] * cn + pn * sn; }
#pragma unroll
                    for (int bj = 0; bj < 2; ++bj) *(u32x4*)(dst + (size_t)row * 1024 + gidx * 64 + 32 * bj + 8 * fq) = pack8(y[bj][0] * osc, y[bj][1] * osc);
                } }
        }
    }
};

struct EpiConvIn {
    static constexpr bool PERM = true, AFTER_DRAIN = false;
    bf16_t* BG; bf16_t* U2; const float* ssq; const float* bias;
    __device__ __forceinline__ void operator()(const f32x4 (&acc)[2][2][4][2], const Unit& u, int wr, int wc, int fr, int fq) const {
        float rsv8[2][4]; row_rstd8(ssq, u.pm * 256 + wr * 64 + fr, fq, rsv8);
        const int b = u.pm >> 5, bcol = u.pn * 256 + wc * 32 + 8 * fq;
        f32x4 bv[2][2];
#pragma unroll
        for (int bj = 0; bj < 2; ++bj)
#pragma unroll
            for (int n = 0; n < 2; ++n) bv[bj][n] = *(const f32x4*)(bias + b * BIAS_LD + bcol + 128 * bj + 4 * n);
        if (u.pn < 8) {
#pragma unroll
            for (int ai = 0; ai < 2; ++ai) {
#pragma unroll
                for (int m = 0; m < 4; ++m) { const int row = u.pm * 256 + ai * 128 + wr * 64 + m * 16 + fr; const float rs = rsv8[ai][m];
                    const f32x4 c0 = acc[ai][0][m][0] * rs + bv[0][0], c1 = acc[ai][0][m][1] * rs + bv[0][1], u0 = acc[ai][1][m][0] * rs + bv[1][0], u1 = acc[ai][1][m][1] * rs + bv[1][1];
                    *(u32x4*)(U2 + (size_t)row * 1024 + u.pn * 128 + wc * 32 + 8 * fq) =
#if defined(CONV_CG)
                        pack8(c0, c1);
#elif defined(CONV_U)
                        pack8(u0, u1);
#else
                        pack8(c0 * u0, c1 * u1);
#endif
                } }
        } else {
#pragma unroll
            for (int ai = 0; ai < 2; ++ai) {
#pragma unroll
                for (int m = 0; m < 4; ++m) { const int row = u.pm * 256 + ai * 128 + wr * 64 + m * 16 + fr; const float rs = rsv8[ai][m];
#pragma unroll
                    for (int bj = 0; bj < 2; ++bj) *(u32x4*)(BG + (size_t)row * 1024 + (u.pn - 8) * 256 + 128 * bj + wc * 32 + 8 * fq) = pack8(acc[ai][bj][m][0] * rs + bv[bj][0], acc[ai][bj][m][1] * rs + bv[bj][1]); } }
        }
    }
};

template <class Epi, class Sched, bool ALIGN_EPI = false, bool SP2 = false>
__device__ __forceinline__ void gemm_phase(PG8_LAS unsigned char* lds, const Gemm g, const Sched& S, const Epi& E) {
    const int tid = opaque_tid(), wid = __builtin_amdgcn_readfirstlane(tid >> 6), lane = tid & 63, wr = wid >> 2, wc = wid & 3, fr = lane & 15, fq = lane >> 4;
    const int K = g.K, nt = K / BK;
    unsigned voffA[2], voffB[2];
#pragma unroll
    for (int i = 0; i < 2; ++i) { int R, C; stage_rc(tid * 16 + i * 8192, R, C); const int Rb = Epi::PERM ? ((R & ~31) + perm32(R & 31)) : R;
        voffA[i] = (unsigned)(R * K + C) * 2u; voffB[i] = (unsigned)(Rb * K + C) * 2u; }
    const size_t kstep = (size_t)(BK * 2);
    const size_t hstep = (size_t)HALF * K * 2;
    const size_t tstep = 2 * hstep;
    const unsigned ldsw = (unsigned)wid * 1024u;
    const int aoff = lds_byte(wr * 64 + fr, fq * 8), boff = lds_byte(wc * 32 + fr, fq * 8);
#define PG8_SA(b, h) (((b) * 2 + (h)) * HTB)
#define PG8_SB(b, h) ((4 + (b) * 2 + (h)) * HTB)
#define PG8_STAGE(bufoff, gbase, voff) do { _Pragma("unroll") for (int _i = 0; _i < 2; ++_i) \
        __builtin_amdgcn_global_load_lds((const unsigned*)((const char*)(gbase) + (voff)[_i]), (PG8_LAS unsigned*)(lds + (bufoff) + ldsw + _i * 8192), 16, 0, 0); } while (0)
#define PG8_LDA(dst, b, h) do { _Pragma("unroll") for (int m = 0; m < 4; ++m) _Pragma("unroll") for (int k = 0; k < 2; ++k) dst[m][k] = *(const PG8_LAS bf16x8*)(lds + PG8_SA(b, h) + aoff + m * 2048 + k * 1024); } while (0)
#define PG8_LDB(dst, b, h) do { _Pragma("unroll") for (int n = 0; n < 2; ++n) _Pragma("unroll") for (int k = 0; k < 2; ++k) dst[n][k] = *(const PG8_LAS bf16x8*)(lds + PG8_SB(b, h) + boff + n * 2048 + k * 1024); } while (0)
#define PG8_MMA(ai, bj, At, Bt) do { __builtin_amdgcn_s_setprio(1); _Pragma("unroll") for (int m = 0; m < 4; ++m) _Pragma("unroll") for (int n = 0; n < 2; ++n) _Pragma("unroll") for (int k = 0; k < 2; ++k) \
        acc[ai][bj][m][n] = __builtin_amdgcn_mfma_f32_16x16x32_bf16(Bt[n][k], At[m][k], acc[ai][bj][m][n], 0, 0, 0); __builtin_amdgcn_s_setprio(0); } while (0)
#define PG8_WAIT_V(n) asm volatile("s_waitcnt vmcnt(" #n ")" ::: "memory")
#define PG8_WAIT_L(n) asm volatile("s_waitcnt lgkmcnt(" #n ")" ::: "memory")
#define PG8_BAR __builtin_amdgcn_s_barrier()
#define PG8_SCHED __builtin_amdgcn_sched_barrier(0)
    Unit cur, nxt; int ui = 0;
    if (!S.next(0, cur)) return;
    f32x4 acc[2][2][4][2];
#pragma unroll
    for (int a = 0; a < 2; ++a)
#pragma unroll
        for (int b = 0; b < 2; ++b)
#pragma unroll
            for (int m = 0; m < 4; ++m)
#pragma unroll
                for (int n = 0; n < 2; ++n) acc[a][b][m][n] = (f32x4){0.f, 0.f, 0.f, 0.f};
    bf16x8 At[4][2], B0[2][2], B1[2][2];
    const char* cA = (const char*)g.A + (size_t)cur.pm * tstep; const char* cB = (const char*)g.Bt + (size_t)cur.pn * tstep;
    S.a_ready(cur);
    if constexpr (SP2) {
        PG8_STAGE(PG8_SB(0, 0), cB, voffB); PG8_STAGE(PG8_SB(0, 1), cB + hstep, voffB); PG8_STAGE(PG8_SA(0, 0), cA, voffA); PG8_STAGE(PG8_SA(0, 1), cA + hstep, voffA);
        if (wr == 1) PG8_BAR;
        PG8_WAIT_V(2); PG8_BAR;
        PG8_STAGE(PG8_SB(1, 0), cB + kstep, voffB); PG8_STAGE(PG8_SA(1, 0), cA + kstep, voffA); PG8_STAGE(PG8_SB(1, 1), cB + hstep + kstep, voffB);
        PG8_WAIT_V(6); PG8_BAR;
    } else {
        PG8_STAGE(PG8_SB(0, 0), cB, voffB); PG8_STAGE(PG8_SA(0, 0), cA, voffA); PG8_STAGE(PG8_SB(0, 1), cB + hstep, voffB); PG8_STAGE(PG8_SA(0, 1), cA + hstep, voffA);
        if (wr == 1) PG8_BAR;
        PG8_WAIT_V(4); PG8_BAR;
        PG8_STAGE(PG8_SB(1, 0), cB + kstep, voffB); PG8_STAGE(PG8_SA(1, 0), cA + kstep, voffA); PG8_STAGE(PG8_SB(1, 1), cB + hstep + kstep, voffB);
        PG8_WAIT_V(6); PG8_BAR;
    }
    for (;;) {
        const bool has_next = S.next(ui + 1, nxt);
        const char* nA = has_next ? (const char*)g.A + (size_t)nxt.pm * tstep : cA; const char* nB = has_next ? (const char*)g.Bt + (size_t)nxt.pn * tstep : cB;
        for (int t = 0; t < nt; t += 2) {
            const bool last = (t == nt - 2);
            const char* a1 = cA + (size_t)(t + 1) * kstep;
            const char* a2 = last ? nA : cA + (size_t)(t + 2) * kstep; const char* b2 = last ? nB : cB + (size_t)(t + 2) * kstep;
            const char* a3 = a2 + kstep; const char* b3 = b2 + kstep;
            if (last && has_next) S.a_ready(nxt);
            if constexpr (SP2) {
            PG8_LDB(B0, 0, 0); PG8_LDB(B1, 0, 1); PG8_SCHED; PG8_LDA(At, 0, 0); PG8_STAGE(PG8_SA(1, 1), a1 + hstep, voffA);
            PG8_WAIT_V(8); PG8_WAIT_L(0); PG8_BAR; PG8_MMA(0, 0, At, B0); PG8_MMA(0, 1, At, B1); PG8_BAR; PG8_SCHED;
            PG8_LDA(At, 0, 1); PG8_STAGE(PG8_SB(0, 0), b2, voffB); PG8_STAGE(PG8_SB(0, 1), b2 + hstep, voffB); PG8_STAGE(PG8_SA(0, 0), a2, voffA);
            PG8_WAIT_V(8); PG8_WAIT_L(0); PG8_BAR; PG8_MMA(1, 0, At, B0); PG8_MMA(1, 1, At, B1); PG8_BAR; PG8_SCHED;
            PG8_LDB(B0, 1, 0); PG8_LDB(B1, 1, 1); PG8_SCHED; PG8_LDA(At, 1, 0); PG8_STAGE(PG8_SA(0, 1), a2 + hstep, voffA);
            PG8_WAIT_V(8); PG8_WAIT_L(0); PG8_BAR; PG8_MMA(0, 0, At, B0); PG8_MMA(0, 1, At, B1); PG8_BAR; PG8_SCHED;
            PG8_LDA(At, 1, 1); PG8_STAGE(PG8_SB(1, 0), b3, voffB); PG8_STAGE(PG8_SB(1, 1), b3 + hstep, voffB); PG8_STAGE(PG8_SA(1, 0), a3, voffA);
            PG8_WAIT_V(8); PG8_WAIT_L(0); PG8_BAR; PG8_MMA(1, 0, At, B0); PG8_MMA(1, 1, At, B1); PG8_BAR; PG8_SCHED;
            } else {
            PG8_LDB(B0, 0, 0); PG8_SCHED; PG8_LDA(At, 0, 0); PG8_STAGE(PG8_SA(1, 1), a1 + hstep, voffA);
            PG8_WAIT_L(8); PG8_BAR; PG8_WAIT_L(0); PG8_MMA(0, 0, At, B0); PG8_BAR; PG8_SCHED;
            PG8_LDB(B1, 0, 1); PG8_STAGE(PG8_SB(0, 0), b2, voffB);
            PG8_BAR; PG8_WAIT_L(0); PG8_MMA(0, 1, At, B1); PG8_BAR;
            PG8_LDA(At, 0, 1); PG8_STAGE(PG8_SA(0, 0), a2, voffA);
            PG8_BAR; PG8_WAIT_L(0); PG8_MMA(1, 0, At, B0); PG8_BAR; PG8_SCHED;
            PG8_STAGE(PG8_SB(0, 1), b2 + hstep, voffB);
            PG8_WAIT_V(6); PG8_BAR; PG8_MMA(1, 1, At, B1); PG8_BAR;
            PG8_LDB(B0, 1, 0); PG8_SCHED; PG8_LDA(At, 1, 0); PG8_STAGE(PG8_SA(0, 1), a2 + hstep, voffA);
            PG8_WAIT_L(8); PG8_BAR; PG8_WAIT_L(0); PG8_MMA(0, 0, At, B0); PG8_BAR; PG8_SCHED;
            PG8_LDB(B1, 1, 1); PG8_STAGE(PG8_SB(1, 0), b3, voffB);
            PG8_BAR; PG8_WAIT_L(0); PG8_MMA(0, 1, At, B1); PG8_BAR;
            PG8_LDA(At, 1, 1); PG8_STAGE(PG8_SA(1, 0), a3, voffA);
            PG8_BAR; PG8_WAIT_L(0); PG8_MMA(1, 0, At, B0); PG8_BAR; PG8_SCHED;
            PG8_STAGE(PG8_SB(1, 1), b3 + hstep, voffB);
            PG8_WAIT_V(6); PG8_BAR; PG8_MMA(1, 1, At, B1); PG8_BAR;
            }
        }
        if constexpr (ALIGN_EPI) { if (wr == 0) PG8_BAR; }
        if constexpr (!Epi::AFTER_DRAIN) { E(acc, cur, wr, wc, fr, fq); S.done(cur); }
        if (!has_next) break;
#pragma unroll
        for (int a = 0; a < 2; ++a)
#pragma unroll
            for (int b = 0; b < 2; ++b)
#pragma unroll
                for (int m = 0; m < 4; ++m)
#pragma unroll
                    for (int n = 0; n < 2; ++n) acc[a][b][m][n] = (f32x4){0.f, 0.f, 0.f, 0.f};
        cur = nxt; cA = nA; cB = nB; ++ui;
        if constexpr (ALIGN_EPI) { if (wr == 1) PG8_BAR; }
    }
    PG8_WAIT_V(0);
    if constexpr (!ALIGN_EPI) { if (wr == 0) PG8_BAR; }
    PG8_BAR;
    if constexpr (Epi::AFTER_DRAIN) { E.fused(acc, cur, wr, wc, fr, fq, lds, wid, lane); S.done(cur); }
#undef PG8_SA
#undef PG8_SB
#undef PG8_STAGE
#undef PG8_LDA
#undef PG8_LDB
#undef PG8_MMA
#undef PG8_WAIT_V
#undef PG8_WAIT_L
#undef PG8_BAR
#undef PG8_SCHED
}
}
#include <hip/hip_bf16.h>
#include <cmath>
namespace attn_body {
using bf16=__hip_bfloat16;
using bf16x8=__attribute__((ext_vector_type(8)))short;
using s16x4=__attribute__((ext_vector_type(4)))short;
using f32x16=__attribute__((ext_vector_type(16)))float;
using u32x4=__attribute__((ext_vector_type(4)))unsigned;
constexpr int BATCH=4,NHEAD=16,SEQ=8192,D=64,DM=NHEAD*D;
constexpr int NW=8,QBLK=32,QB=QBLK*NW,KVBLK=64,NQB=SEQ/QB;
constexpr int ATTN_PITCH=DM, ATTN_UNIT_ROWS=QB;
__device__ __forceinline__ int crow(int r,int hi){return (r&3)+8*(r>>2)+4*hi;}
#define SBAR() __builtin_amdgcn_sched_barrier(0)
__device__ __forceinline__ void cmask(f32x16&p0,f32x16&p1,int jb,int qrel,int hi){
  const float NEG=-INFINITY; int kb=64*jb+4*hi;
  #pragma unroll
  for(int r=0;r<16;++r){int kv=kb+(r&3)+8*(r>>2); if(kv>qrel)p0[r]=NEG; if(kv+32>qrel)p1[r]=NEG;}
}

constexpr int NSLOT=3, SLOTB=8192;
constexpr int LDS_K=0, LDS_V=NSLOT*SLOTB, LDS_WS=2*NSLOT*SLOTB, LDS_OST=LDS_WS+NW*64*4, LDS_BYTES=LDS_OST+NW*4096;
constexpr float C2=0.125f*1.4426950408889634f;
__device__ __forceinline__ void glds16(const void*gsrc,unsigned lds_dst){unsigned keep;
  asm volatile("s_mov_b32 %0, m0\n\ts_mov_b32 m0, %2\n\ts_nop 0\n\tglobal_load_lds_dwordx4 %1, off\n\ts_mov_b32 m0, %0":"=&s"(keep):"v"(gsrc),"s"(lds_dst):"memory");}
__device__ __forceinline__ float max3f(float a,float b,float c){float r;asm("v_max3_f32 %0, %1, %2, %3":"=v"(r):"v"(a),"v"(b),"v"(c));return r;}
__device__ __forceinline__ float max2f(float a,float b){float r;asm("v_max_f32_e32 %0, %1, %2":"=v"(r):"v"(a),"v"(b));return r;}
__device__ __forceinline__ float fadd_s(float a,float b){float r;asm("v_add_f32_e32 %0, %1, %2":"=v"(r):"v"(a),"v"(b));return r;}
__device__ __forceinline__ float fsub_s(float a,float b){float r;asm("v_sub_f32_e32 %0, %1, %2":"=v"(r):"v"(a),"v"(b));return r;}
typedef float f32x2_t __attribute__((ext_vector_type(2))); typedef __bf16 bf16x2_t __attribute__((ext_vector_type(2)));
__device__ __forceinline__ unsigned cvtpk_s(float lo,float hi){f32x2_t v={lo,hi};bf16x2_t b=__builtin_convertvector(v,bf16x2_t);return __builtin_bit_cast(unsigned,b);}
#define WAIT_BAR(N) asm volatile("s_waitcnt vmcnt(" #N ") lgkmcnt(0)\n\ts_barrier":::"memory")

__device__ __forceinline__ void qkt(f32x16&p0,f32x16&p1,const char*Kslot,const bf16x8*qr,const f32x16&negm,int r32,int hi){
  const char*kb=Kslot+hi*1024+r32*16;
  #pragma unroll
  for(int d0=0;d0<4;++d0){
    const bf16x8 b0=*reinterpret_cast<const bf16x8*>(kb+d0*2048);
    const bf16x8 b1=*reinterpret_cast<const bf16x8*>(kb+d0*2048+512);
    if(d0==0){p0=__builtin_amdgcn_mfma_f32_32x32x16_bf16(b0,qr[0],negm,0,0,0);p1=__builtin_amdgcn_mfma_f32_32x32x16_bf16(b1,qr[0],negm,0,0,0);}
    else{p0=__builtin_amdgcn_mfma_f32_32x32x16_bf16(b0,qr[d0],p0,0,0,0);p1=__builtin_amdgcn_mfma_f32_32x32x16_bf16(b1,qr[d0],p1,0,0,0);}}
}
typedef __attribute__((address_space(3))) const char* lds_cptr;
typedef short v4i16_t __attribute__((ext_vector_type(4)));
__device__ __forceinline__ void kload8(bf16x8*kf,lds_cptr kp){
  kf[0]=*(const __attribute__((address_space(3))) bf16x8*)(kp);      kf[1]=*(const __attribute__((address_space(3))) bf16x8*)(kp+512);
  kf[2]=*(const __attribute__((address_space(3))) bf16x8*)(kp+2048); kf[3]=*(const __attribute__((address_space(3))) bf16x8*)(kp+2560);
  kf[4]=*(const __attribute__((address_space(3))) bf16x8*)(kp+4096); kf[5]=*(const __attribute__((address_space(3))) bf16x8*)(kp+4608);
  kf[6]=*(const __attribute__((address_space(3))) bf16x8*)(kp+6144); kf[7]=*(const __attribute__((address_space(3))) bf16x8*)(kp+6656);
}
__device__ __forceinline__ void kload2(bf16x8*kf,lds_cptr kp,int j){ kf[2*j]=*(const __attribute__((address_space(3))) bf16x8*)(kp+j*2048); kf[2*j+1]=*(const __attribute__((address_space(3))) bf16x8*)(kp+j*2048+512); }
__device__ __forceinline__ s16x4 vtr(lds_cptr p){ return __builtin_bit_cast(s16x4,__builtin_amdgcn_ds_read_tr16_b64_v4i16((__attribute__((address_space(3))) v4i16_t*)p)); }
__device__ __forceinline__ float rowmax(const f32x16&p0,const f32x16&p1){
  float a=max3f(p0[0],p0[1],p1[0]),b=max3f(p0[2],p0[3],p1[1]);a=max3f(a,p1[2],p1[3]);
  #pragma unroll
  for(int r=4;r<16;r+=4){a=max3f(a,p0[r],p0[r+1]);b=max3f(b,p0[r+2],p0[r+3]);a=max3f(a,p1[r],p1[r+1]);b=max3f(b,p1[r+2],p1[r+3]);}
  const float m=max2f(a,b);
  auto rr=__builtin_amdgcn_permlane32_swap(__float_as_uint(m),__float_as_uint(m),false,false);
  return max2f(__uint_as_float(rr[0]),__uint_as_float(rr[1]));
}
__device__ __forceinline__ void pv(f32x16*o,int vb,bf16x8 pa0,bf16x8 pa1,bf16x8 pa2,bf16x8 pa3){
  #pragma unroll
  for(int d0=0;d0<2;++d0){s16x4 lo[4],hi[4];
    #pragma unroll
    for(int ks=0;ks<4;++ks){
      asm volatile("ds_read_b64_tr_b16 %0,%1 offset:%c2":"=&v"(lo[ks]):"v"(vb),"i"(d0*4096+ks*1024):"memory");
      asm volatile("ds_read_b64_tr_b16 %0,%1 offset:%c2":"=&v"(hi[ks]):"v"(vb),"i"(d0*4096+ks*1024+512):"memory");}
    asm volatile("s_waitcnt lgkmcnt(0)":::"memory");SBAR();
    #define PK(k) (bf16x8){lo[k][0],lo[k][1],lo[k][2],lo[k][3],hi[k][0],hi[k][1],hi[k][2],hi[k][3]}
    o[d0]=__builtin_amdgcn_mfma_f32_32x32x16_bf16(pa0,PK(0),o[d0],0,0,0);
    o[d0]=__builtin_amdgcn_mfma_f32_32x32x16_bf16(pa1,PK(1),o[d0],0,0,0);
    o[d0]=__builtin_amdgcn_mfma_f32_32x32x16_bf16(pa2,PK(2),o[d0],0,0,0);
    o[d0]=__builtin_amdgcn_mfma_f32_32x32x16_bf16(pa3,PK(3),o[d0],0,0,0);
    #undef PK
  }
}

#ifndef ATTN_STORE16
#define ATTN_STORE16(p,v) (*(u32x4*)(p)=(v))
#endif
template<int THRL> __device__ __forceinline__ void attn_unit(int b,int qc,int vc,int qb,const bf16*Q,const bf16*__restrict__ K,const bf16*__restrict__ V,bf16*O,char*shm){
  const int tid=opaque_tid(),lane=tid&63,r32=lane&31,hi=lane>>5; const int wid=__builtin_amdgcn_readfirstlane(tid>>6);
  const long rowbase=(long)b*SEQ; const int q0=qb*QB;
  const bf16*Qw=Q+(rowbase+q0+wid*QBLK)*DM+qc;
  const bf16*Kh=K+rowbase*DM+qc,*Vh=V+rowbase*DM+vc;
  const unsigned lds0=(unsigned)(uintptr_t)shm;
  float*wsf=(float*)(shm+LDS_WS)+wid*64;
  const bf16*ksrc=Kh+(long)lane*DM+wid*8;
  const bf16*vsrc=Vh+(long)(16*(wid&3)+(lane>>2))*DM+(wid>>2)*32+(lane&3)*8;
  const unsigned kdst=lds0+LDS_K+wid*1024, vdst=lds0+LDS_V+wid*1024;
  #define DMA_K(t,slot) glds16(ksrc+(long)(t)*KVBLK*DM,(unsigned)__builtin_amdgcn_readfirstlane(kdst+(slot)))
  #define DMA_V(t,slot) glds16(vsrc+(long)(t)*KVBLK*DM,(unsigned)__builtin_amdgcn_readfirstlane(vdst+(slot)))
  const int vb0=(int)(lds0+LDS_V)+((lane>>4)&1)*32+(lane&3)*8+(4*hi+((lane&15)>>2))*64;
  const char*Kbase=shm+LDS_K; bf16x8 kf[8];
  const lds_cptr shm3=(lds_cptr)shm; const lds_cptr kp0=shm3+LDS_K+hi*1024+r32*16; const lds_cptr vp0=shm3+LDS_V+((lane>>4)&1)*32+(lane&3)*8+(4*hi+((lane&15)>>2))*64;
  const int NT=(q0+QB)/KVBLK;
  DMA_K(0,0);DMA_V(0,0);DMA_K(1,SLOTB);
  bf16x8 qr[4];
  #pragma unroll
  for(int d0=0;d0<4;++d0)qr[d0]=*reinterpret_cast<const bf16x8*>(&Qw[(long)r32*DM+d0*16+hi*8]);
  float mhat=0.f,l_reg=0.f;f32x16 o[2];o[0]=f32x16{};o[1]=f32x16{};f32x16 negm=f32x16{};asm volatile("":"+v"(negm));
  const int qrel=wid*QBLK+r32;
  #define CMASK(P0,P1,t) do{int jb_=(t)-(NT-4); if(jb_>=0)cmask(P0,P1,jb_,qrel,hi);}while(0)
  bool resc=false;
  #define START(P0,P1) do{ const float rm=rowmax(P0,P1); resc=false; \
    { const float dl=rm; mhat=fadd_s(mhat,dl); \
      _Pragma("unroll") for(int r=0;r<16;++r){P0[r]=fsub_s(P0[r],dl);P1[r]=fsub_s(P1[r],dl);} \
      _Pragma("unroll") for(int r=0;r<16;++r)negm[r]=-mhat; asm volatile("":"+v"(negm)); } \
    _Pragma("unroll") for(int r=0;r<16;++r)P0[r]=__builtin_amdgcn_exp2f(P0[r]); }while(0)
  #define RESC() do{ if(resc){ asm volatile("s_waitcnt lgkmcnt(0)":::"memory"); \
      _Pragma("unroll") for(int d_=0;d_<2;++d_) _Pragma("unroll") for(int r=0;r<16;++r)o[d_][r]*=wsf[crow(r,hi)]; } }while(0)
  f32x16 pA0,pA1,pB0,pB1;
  int sl_prev=0,sl_cur=0,sl_next=SLOTB;
  #define ROT() do{sl_prev=sl_cur;sl_cur=sl_next;sl_next=(sl_next==(NSLOT-1)*SLOTB)?0:sl_next+SLOTB;}while(0)
  DMA_K(2,2*SLOTB);
  WAIT_BAR(3);
  qkt(pA0,pA1,Kbase,qr,negm,r32,hi);asm volatile("s_nop 15\n\ts_nop 7":"+v"(pA0),"+v"(pA1));CMASK(pA0,pA1,0);
  START(pA0,pA1);
  _Pragma("unroll") for(int r=0;r<16;++r)pA1[r]=__builtin_amdgcn_exp2f(pA1[r]);
  WAIT_BAR(0);
  DMA_K(3,0);DMA_V(1,SLOTB);
  ROT();
  kload8(kf,kp0+sl_cur);
  WAIT_BAR(2);
  s16x4 vlo[8],vhi[8]; u32x4 pw0,pw1,pw2,pw3;
  #define PKW(P,B) cvtpk_s(P[B],P[B+1])
  #define PAF(k) __builtin_bit_cast(bf16x8,pw##k)
  #define VFR(i) (bf16x8){vlo[i][0],vlo[i][1],vlo[i][2],vlo[i][3],vhi[i][0],vhi[i][1],vhi[i][2],vhi[i][3]}
  #define PIN(x) asm volatile("":"+v"(x))
  #define MX3(a,b,c) __builtin_fmaxf(__builtin_fmaxf((a),(b)),(c))
  #define GAPA(MF,A0,A1,A2,A3,W0,W1,PW) do{ MF; sacc+=A0; sacc+=A1; sacc+=A2; sacc+=A3; PIN(sacc); W0; W1; PIN(PW); SBAR(); }while(0)
  #define EX(v) __builtin_amdgcn_exp2f(v)
  #define GAPB(MF,X,B) do{ MF; X[B]=EX(X[B]); X[B+1]=EX(X[B+1]); X[B+2]=EX(X[B+2]); X[B+3]=EX(X[B+3]); PIN(X); SBAR(); }while(0)
  #define VRD(i) do{ vlo[i]=vtr(vp_+(((i)>>2)*4096+((i)&3)*1024)); vhi[i]=vtr(vp_+(((i)>>2)*4096+((i)&3)*1024+512)); }while(0)
  #define KRD(G,j) do{ if(G){ kload2(kf,kp0+sl_next,j); SBAR(); } }while(0)
  #define STEP(C0,C1,P0,P1,t,GK,GV,GL) do{ SBAR(); \
    const lds_cptr vp_=vp0+sl_prev; \
    VRD(0); SBAR(); float sacc=(P0[0]+P0[1]); \
    GAPA(C0=__builtin_amdgcn_mfma_f32_32x32x16_bf16(kf[0],qr[0],negm,0,0,0), P0[2],P0[3],P0[4],P0[5],     pw0[0]=PKW(P0,0), pw0[1]=PKW(P0,2), pw0); \
    VRD(4); SBAR(); GAPA(C1=__builtin_amdgcn_mfma_f32_32x32x16_bf16(kf[1],qr[0],negm,0,0,0), P0[6],P0[7],P0[8],P0[9],     pw0[2]=PKW(P0,4), pw0[3]=PKW(P0,6), pw0); \
    VRD(1); SBAR(); GAPA(C0=__builtin_amdgcn_mfma_f32_32x32x16_bf16(kf[2],qr[1],C0,0,0,0),   P0[10],P0[11],P0[12],P0[13], pw1[0]=PKW(P0,8), pw1[1]=PKW(P0,10), pw1); \
    VRD(5); SBAR(); GAPA(C1=__builtin_amdgcn_mfma_f32_32x32x16_bf16(kf[3],qr[1],C1,0,0,0),   P0[14],P0[15],P1[0],P1[1],   pw1[2]=PKW(P0,12),pw1[3]=PKW(P0,14), pw1); \
    VRD(2); SBAR(); GAPA(C0=__builtin_amdgcn_mfma_f32_32x32x16_bf16(kf[4],qr[2],C0,0,0,0),   P1[2],P1[3],P1[4],P1[5],     pw2[0]=PKW(P1,0), pw2[1]=PKW(P1,2), pw2); \
    VRD(6); SBAR(); GAPA(C1=__builtin_amdgcn_mfma_f32_32x32x16_bf16(kf[5],qr[2],C1,0,0,0),   P1[6],P1[7],P1[8],P1[9],     pw2[2]=PKW(P1,4), pw2[3]=PKW(P1,6), pw2); \
    VRD(3); SBAR(); GAPA(C0=__builtin_amdgcn_mfma_f32_32x32x16_bf16(kf[6],qr[3],C0,0,0,0),   P1[10],P1[11],P1[12],P1[13], pw3[0]=PKW(P1,8), pw3[1]=PKW(P1,10), pw3); \
    VRD(7); SBAR(); GAPA(C1=__builtin_amdgcn_mfma_f32_32x32x16_bf16(kf[7],qr[3],C1,0,0,0),   P1[14],P1[15],0.f,0.f,       pw3[2]=PKW(P1,12),pw3[3]=PKW(P1,14), pw3); \
    l_reg+=sacc; \
    if(GK){DMA_K((t)+3,sl_cur);} if(GV){DMA_V((t)+1,sl_next);} \
    CMASK(C0,C1,t); \
    { float a=MX3(C0[0],C0[1],C1[0]),b=MX3(C0[2],C0[3],C1[1]); a=MX3(a,C1[2],C1[3]); \
      _Pragma("unroll") for(int r=4;r<16;r+=4){a=MX3(a,C0[r],C0[r+1]);b=MX3(b,C0[r+2],C0[r+3]);a=MX3(a,C1[r],C1[r+1]);b=MX3(b,C1[r+2],C1[r+3]);} \
      float rm=__builtin_fmaxf(a,b); { auto rr=__builtin_amdgcn_permlane32_swap(__float_as_uint(rm),__float_as_uint(rm),false,false); rm=__builtin_fmaxf(__uint_as_float(rr[0]),__uint_as_float(rr[1])); } \
      resc=false; \
      if(__builtin_expect(__any(rm>(float)THRL),0)){ const float dl=__builtin_fmaxf(rm,0.f); mhat+=dl; \
        _Pragma("unroll") for(int r=0;r<16;++r){C0[r]-=dl;C1[r]-=dl;} \
        _Pragma("unroll") for(int r=0;r<16;++r)negm[r]=-mhat; asm volatile("":"+v"(negm)); \
        const float f=__builtin_amdgcn_exp2f(-dl); l_reg*=f; if(hi==0)wsf[r32]=f; resc=true; } } \
    SBAR(); \
    GAPB(o[0]=__builtin_amdgcn_mfma_f32_32x32x16_bf16(PAF(0),VFR(0),o[0],0,0,0), C0,0); \
    GAPB(o[1]=__builtin_amdgcn_mfma_f32_32x32x16_bf16(PAF(0),VFR(4),o[1],0,0,0), C0,4); \
    KRD(GL,0); GAPB(o[0]=__builtin_amdgcn_mfma_f32_32x32x16_bf16(PAF(1),VFR(1),o[0],0,0,0), C0,8); \
    KRD(GL,1); GAPB(o[1]=__builtin_amdgcn_mfma_f32_32x32x16_bf16(PAF(1),VFR(5),o[1],0,0,0), C0,12); \
    KRD(GL,2); GAPB(o[0]=__builtin_amdgcn_mfma_f32_32x32x16_bf16(PAF(2),VFR(2),o[0],0,0,0), C1,0); \
    KRD(GL,3); GAPB(o[1]=__builtin_amdgcn_mfma_f32_32x32x16_bf16(PAF(2),VFR(6),o[1],0,0,0), C1,4); \
    GAPB(o[0]=__builtin_amdgcn_mfma_f32_32x32x16_bf16(PAF(3),VFR(3),o[0],0,0,0), C1,8); \
    GAPB(o[1]=__builtin_amdgcn_mfma_f32_32x32x16_bf16(PAF(3),VFR(7),o[1],0,0,0), C1,12); \
    }while(0)
  int t=1;
  #undef CMASK
  #define CMASK(P0,P1,t) do{}while(0)
  for(;t+5<NT;t+=2){
    STEP(pB0,pB1,pA0,pA1,t,true,true,true);     WAIT_BAR(2); RESC(); ROT();
    STEP(pA0,pA1,pB0,pB1,t+1,true,true,true);   WAIT_BAR(2); RESC(); ROT();
  }
  #undef CMASK
  #define CMASK(P0,P1,t) do{int jb_=(t)-(NT-4); if(jb_>=0)cmask(P0,P1,jb_,qrel,hi);}while(0)
  #define ENDW(tt) do{ if((tt)+3<NT){WAIT_BAR(2);} else if((tt)+2<NT){WAIT_BAR(1);} else {WAIT_BAR(0);} }while(0)
  for(;t+1<NT;t+=2){
    STEP(pB0,pB1,pA0,pA1,t,(t+3<NT),(t+1<NT),(t+1<NT));       ENDW(t);   RESC(); ROT();
    STEP(pA0,pA1,pB0,pB1,t+1,(t+4<NT),(t+2<NT),(t+2<NT));     ENDW(t+1); RESC(); ROT();
  }
  STEP(pB0,pB1,pA0,pA1,NT-1,false,false,false); RESC();
  { float sacc=pB0[0]+pB0[1]; _Pragma("unroll") for(int r=2;r<16;++r)sacc+=pB0[r]; _Pragma("unroll") for(int r=0;r<16;++r)sacc+=pB1[r]; l_reg+=sacc;
    pw0=(u32x4){PKW(pB0,0),PKW(pB0,2),PKW(pB0,4),PKW(pB0,6)};pw1=(u32x4){PKW(pB0,8),PKW(pB0,10),PKW(pB0,12),PKW(pB0,14)};pw2=(u32x4){PKW(pB1,0),PKW(pB1,2),PKW(pB1,4),PKW(pB1,6)};pw3=(u32x4){PKW(pB1,8),PKW(pB1,10),PKW(pB1,12),PKW(pB1,14)};
    SBAR(); pv(o,vb0+sl_cur,PAF(0),PAF(1),PAF(2),PAF(3)); }
  #undef PKW
  #undef PAF
  #undef VFR
  #undef PIN
  #undef MX3
  #undef GAPA
  #undef GAPB
  #undef EX
  #undef VRD
  #undef KRD
  #undef STEP
  #undef ENDW
  {auto rr=__builtin_amdgcn_permlane32_swap(__float_as_uint(l_reg),__float_as_uint(l_reg),false,false);l_reg=__uint_as_float(rr[0])+__uint_as_float(rr[1]);}
  if(hi==0)wsf[32+r32]=l_reg;asm volatile("s_waitcnt lgkmcnt(0)":::"memory");
  float rli[16];
  #pragma unroll
  for(int r=0;r<16;++r)rli[r]=__builtin_amdgcn_rcpf(wsf[32+crow(r,hi)]);
  bf16*Ow=O+(rowbase+q0+wid*QBLK)*DM+vc;
  { bf16*stg=(bf16*)(shm+LDS_OST)+wid*2048;
    #pragma unroll
    for(int r=0;r<16;++r){const int orow=crow(r,hi);
      #pragma unroll
      for(int d0=0;d0<2;++d0)stg[orow*64+d0*32+r32]=__float2bfloat16(o[d0][r]*rli[r]);}
    asm volatile("s_waitcnt lgkmcnt(0)":::"memory");
    #pragma unroll
    for(int i=0;i<4;++i){const int row=i*8+(lane>>3),ch=lane&7; const u32x4 v=*(const u32x4*)(stg+row*64+ch*8); ATTN_STORE16(Ow+(long)row*DM+ch*8,v);} }
  asm volatile("s_waitcnt lgkmcnt(0)\n\ts_barrier":::"memory");
  #undef DMA_K
  #undef DMA_V
  #undef CMASK
  #undef START
  #undef RESC
  #undef ROT
}
constexpr int ATTN_LDS_BYTES=LDS_BYTES;
struct AttnTensors { const bf16* Q; const bf16* K; const bf16* V; bf16* O0; bf16* O1; };
struct AttnUnit { int bvh; int qb; };
struct DiffOrder {
  int vcu, G, blk;
  __device__ __forceinline__ explicit DiffOrder(int grid,int block):vcu((grid%8==0)?(block%8)*(grid/8)+block/8:block),G(grid),blk(block){}
  __device__ __forceinline__ bool next(int i,AttnUnit&u)const{
#ifdef ATTN_PAIR
    if(G==256){ if(i>=16)return false; const int r=i>>1,ii=i&1,w=vcu&15,grp=vcu>>4; u.bvh=(r>>1)*32+(grp>>1)*4+(r&1)*2+(grp&1); u.qb=ii?31-w:w; return true; }
#else
    if(G==256){ if(i>=16)return false; const int g=i>>2,ii=i&3,s=vcu&7; u.bvh=(vcu>>3)+32*g; u.qb=(ii==0)?31-s:(ii==1)?16+s:(ii==2)?15-s:s; return true; }
#endif
    const int L=i*G+blk; if(L>=4096)return false; u.qb=31-(L>>7); u.bvh=L&127; return true; }
};
template<int THRL=8> __device__ __forceinline__ void attn_phase(char*lds,const AttnTensors&T,const DiffOrder&S){
  AttnUnit u;
  for(int i=0;S.next(i,u);++i){ const int b=u.bvh>>5,vh=u.bvh&31,h=vh>>2,c=(vh>>1)&1,half=vh&1;
    attn_unit<THRL>(b,(2*h+c)*64,h*128+half*64,u.qb,T.Q,T.K,T.V,c?T.O1:T.O0,lds); }
}
#undef SBAR
#undef WAIT_BAR
}
namespace cg = cooperative_groups;
#define LAS __attribute__((address_space(3)))
typedef unsigned short bf16;
typedef unsigned v4u __attribute__((ext_vector_type(4)));
typedef unsigned v2u __attribute__((ext_vector_type(2)));
typedef float f32x4 __attribute__((ext_vector_type(4)));
typedef short bf16x8 __attribute__((ext_vector_type(8)));

constexpr int M_ROWS = 32768, DM = 1024, FF = 2816;
constexpr size_t MiB = 1u << 20;
constexpr size_t WS_MOD = 0;
constexpr size_t WS_BIAS = 1 * MiB;
constexpr size_t WS_SSQ = 3 * MiB;
constexpr size_t WS_ROPE = 5 * MiB;
constexpr size_t WS_WI = 8 * MiB;
constexpr size_t WS_WO = 96 * MiB;
constexpr size_t WS_AIN = 140 * MiB;
constexpr size_t WS_AOUT = 156 * MiB;
constexpr size_t WS_BIN = 160 * MiB;
constexpr size_t WS_BOUT = 166 * MiB;
constexpr size_t WS_CIN = 168 * MiB;
constexpr size_t WS_COUT = 174 * MiB;
constexpr size_t WS_XG = 176 * MiB;
constexpr size_t WS_SCR = 240 * MiB;
constexpr size_t WS_SSQP = 690 * MiB;
constexpr size_t WS_END = 694 * MiB;
constexpr size_t ACT = 64 * MiB;

__device__ __forceinline__ float bf_lo(unsigned u) { return __uint_as_float(u << 16); }
__device__ __forceinline__ float bf_hi(unsigned u) { return __uint_as_float(u & 0xffff0000u); }
__device__ __forceinline__ float bf2f(bf16 v) { return __uint_as_float((unsigned)v << 16); }
__device__ __forceinline__ unsigned pk2(float lo, float hi) { return pg8::cvt_pk_bf16(lo, hi); }
__device__ __forceinline__ bf16 f2bf(float f) { return (bf16)(pk2(f, 0.f) & 0xffffu); }
__device__ __forceinline__ float wave_sum(float v) {
#pragma unroll
    for (int o = 1; o < 64; o <<= 1) v += __shfl_xor(v, o);
    return v;
}
#define LDS_WAIT() asm volatile("s_waitcnt lgkmcnt(0)" ::: "memory")

__device__ __forceinline__ void tr_item(const float* W, int K, int Nsrc, bf16* WT, int k0, int n0dst, int n0src, LAS float* scr, int lane) {
    float wv[32];
#pragma unroll
    for (int i = 0; i < 32; ++i) wv[i] = __builtin_nontemporal_load(W + (size_t)(k0 + 2 * i + (lane >> 5)) * Nsrc + n0src + (lane & 31));
#pragma unroll
    for (int i = 0; i < 32; ++i) scr[(2 * i + (lane >> 5)) * 33 + (lane & 31)] = wv[i];
    LDS_WAIT(); asm volatile("" ::: "memory");
    const int c = lane & 7;
#pragma unroll
    for (int j = 0; j < 4; ++j) { const int n = (lane >> 3) + 8 * j; const LAS float* s = scr + (8 * c) * 33 + n;
        v4u o; o.x = pk2(s[0 * 33], s[1 * 33]); o.y = pk2(s[2 * 33], s[3 * 33]); o.z = pk2(s[4 * 33], s[5 * 33]); o.w = pk2(s[6 * 33], s[7 * 33]);
        *(v4u*)(WT + (size_t)(n0dst + n) * K + k0 + 8 * c) = o; }
    LDS_WAIT(); asm volatile("" ::: "memory");
}

__device__ __forceinline__ void hgrn_local(LAS unsigned char* L, const float* LOGF, const bf16* V, bf16* SLOC, float* DEC, int blk, int G, int tid) {
    LAS float* TOT = (LAS float*)L;
    LAS bf16* KT = (LAS bf16*)(L + 2048);
    LAS bf16* VT = (LAS bf16*)(L + 2048 + 18432);
    const int k = tid & 127, tq = tid >> 7, lane = tid & 63, wave = tid >> 6, fr = lane & 15, fq = lane >> 4;
    float lf[16]; v4u va, vb;
#define HL_LOAD(it_) do { const int h_ = (it_) & 7; const size_t r0_ = (size_t)((it_) >> 3) * 64; const float* lp_ = LOGF + (r0_ + tq * 16) * 1024 + h_ * 128 + k; \
        _Pragma("unroll") for (int i = 0; i < 16; ++i) lf[i] = lp_[(size_t)i * 1024]; \
        const bf16* vp_ = V + (r0_ + lane) * 1024 + h_ * 128 + wave * 16; va = *(const v4u*)vp_; vb = *(const v4u*)(vp_ + 8); } while (0)
    if (blk < 4096) HL_LOAD(blk);
    for (int item = blk; item < 4096; item += G) {
        float cs[16]; float run = 0.f; float ex[16];
#pragma unroll
        for (int i = 0; i < 16; ++i) { run += lf[i]; cs[i] = run; ex[i] = 1.0f - __expf(lf[i]); }
        TOT[tq * 128 + k] = run;
        { const unsigned vv[8] = {va.x, va.y, va.z, va.w, vb.x, vb.y, vb.z, vb.w};
#pragma unroll
          for (int e = 0; e < 8; ++e) { VT[(wave * 16 + 2 * e) * 72 + lane] = (bf16)(vv[e] & 0xffffu); VT[(wave * 16 + 2 * e + 1) * 72 + lane] = (bf16)(vv[e] >> 16); } }
        __syncthreads();
        if (item + G < 4096) HL_LOAD(item + G);
        float off = 0.f, tot = 0.f;
#pragma unroll
        for (int q = 0; q < 4; ++q) { const float t = TOT[q * 128 + k]; off += (q < tq) ? t : 0.f; tot += t; }
        unsigned pk[8];
#pragma unroll
        for (int i = 0; i < 8; ++i) pk[i] = pk2(ex[2 * i] * __expf(tot - (off + cs[2 * i])), ex[2 * i + 1] * __expf(tot - (off + cs[2 * i + 1])));
        *(LAS v4u*)(KT + k * 72 + tq * 16) = (v4u){pk[0], pk[1], pk[2], pk[3]};
        *(LAS v4u*)(KT + k * 72 + tq * 16 + 8) = (v4u){pk[4], pk[5], pk[6], pk[7]};
        if (tq == 0) DEC[(size_t)item * 128 + k] = __expf(tot);
        __syncthreads();
        const bf16x8 a0 = *(const LAS bf16x8*)(KT + (16 * wave + fr) * 72 + 8 * fq), a1 = *(const LAS bf16x8*)(KT + (16 * wave + fr) * 72 + 32 + 8 * fq);
        bf16* sp = SLOC + (size_t)item * 16384 + 16 * wave + 4 * fq;
#pragma unroll
        for (int nt = 0; nt < 8; ++nt) {
            const bf16x8 b0 = *(const LAS bf16x8*)(VT + (16 * nt + fr) * 72 + 8 * fq), b1 = *(const LAS bf16x8*)(VT + (16 * nt + fr) * 72 + 32 + 8 * fq);
            f32x4 c = {0.f, 0.f, 0.f, 0.f};
            c = __builtin_amdgcn_mfma_f32_16x16x32_bf16(a0, b0, c, 0, 0, 0); c = __builtin_amdgcn_mfma_f32_16x16x32_bf16(a1, b1, c, 0, 0, 0);
            *(v2u*)(sp + (16 * nt + fr) * 128) = (v2u){pk2(c[0], c[1]), pk2(c[2], c[3])};
        }
        __syncthreads();
    }
#undef HL_LOAD
}

__device__ __forceinline__ void hgrn_scan(bf16* SLOC, const float* DEC, int blk, int G, int tid) {
    for (int e = blk * 512 + tid; e < 131072; e += G * 512) {
        const int bh = e >> 12, idx4 = e & 4095, dv = idx4 >> 5, dk4 = (idx4 & 31) * 4, b = bh >> 3, h = bh & 7;
        f32x4 s = {0.f, 0.f, 0.f, 0.f};
        v2u loc[8]; f32x4 d[8]; v2u locn[8]; f32x4 dn[8];
#define HS_LOAD(L_, D_, c0_) do { _Pragma("unroll") for (int i = 0; i < 8; ++i) { const size_t it_ = (size_t)(b * 128 + (c0_) + i) * 8 + h; L_[i] = *(const v2u*)(SLOC + it_ * 16384 + dv * 128 + dk4); D_[i] = *(const f32x4*)(DEC + it_ * 128 + dk4); } } while (0)
#define HS_STEP(L_, D_, c0_) do { _Pragma("unroll") for (int i = 0; i < 8; ++i) { const size_t it_ = (size_t)(b * 128 + (c0_) + i) * 8 + h; \
            *(v2u*)(SLOC + it_ * 16384 + dv * 128 + dk4) = (v2u){pk2(s[0], s[1]), pk2(s[2], s[3])}; \
            const f32x4 lv = {bf_lo(L_[i].x), bf_hi(L_[i].x), bf_lo(L_[i].y), bf_hi(L_[i].y)}; s = D_[i] * s + lv; } } while (0)
        HS_LOAD(loc, d, 0);
        for (int c0 = 0; c0 < 128; c0 += 16) {
            HS_LOAD(locn, dn, c0 + 8);
            HS_STEP(loc, d, c0);
            if (c0 + 16 < 128) HS_LOAD(loc, d, c0 + 16);
            HS_STEP(locn, dn, c0 + 8);
        }
#undef HS_LOAD
#undef HS_STEP
    }
}

__device__ __forceinline__ void hgrn_out(LAS unsigned char* L, const float* LOGF, bf16* QA, const bf16* V, const bf16* Gt, const bf16* SLOC, const float* onorm, int blk, int G, int tid) {
    LAS float* TOT = (LAS float*)L;
    LAS bf16* QH = (LAS bf16*)(L + 2048);
    LAS bf16* QT = (LAS bf16*)(L + 19456);
    LAS bf16* KL = (LAS bf16*)(L + 36864);
    LAS bf16* VT = (LAS bf16*)(L + 54272);
    LAS bf16* ATT = (LAS bf16*)(L + 72704);
    LAS float* OB = (LAS float*)(L + 81920);
    const int k = tid & 127, tq = tid >> 7, lane = tid & 63, wave = tid >> 6, fr = lane & 15, fq = lane >> 4;
    const int mt = wave >> 1, t_n = tid >> 3, cg8 = tid & 7;
    float lf[16]; unsigned short qraw[16]; v4u va, vb;
#define HO_LOAD(it_) do { const int h_ = (it_) & 7; const size_t r0_ = (size_t)((it_) >> 3) * 64; const float* lp_ = LOGF + (r0_ + tq * 16) * 1024 + h_ * 128 + k; const bf16* qp_ = QA + (r0_ + tq * 16) * 1024 + h_ * 128 + k; \
        _Pragma("unroll") for (int i = 0; i < 16; ++i) { lf[i] = lp_[(size_t)i * 1024]; qraw[i] = qp_[(size_t)i * 1024]; } \
        const bf16* vp_ = V + (r0_ + lane) * 1024 + h_ * 128 + wave * 16; va = *(const v4u*)vp_; vb = *(const v4u*)(vp_ + 8); } while (0)
    if (blk < 4096) HO_LOAD(blk);
    for (int item = blk; item < 4096; item += G) {
        const int h = item & 7; const size_t row0 = (size_t)(item >> 3) * 64;
        bf16x8 sfrag[4][4];
#pragma unroll
        for (int q = 0; q < 4; ++q) { const bf16* sp = SLOC + (size_t)item * 16384 + (16 * ((wave & 1) * 4 + q) + fr) * 128 + 8 * fq;
#pragma unroll
            for (int kk = 0; kk < 4; ++kk) sfrag[q][kk] = *(const bf16x8*)(sp + 32 * kk); }
        const size_t goff = (row0 + t_n) * 1024 + h * 128 + cg8 * 16;
        const v4u g0 = *(const v4u*)(Gt + goff), g1 = *(const v4u*)(Gt + goff + 8);
        float cs[16], qv[16], kx[16]; float run = 0.f;
#pragma unroll
        for (int i = 0; i < 16; ++i) { run += lf[i]; cs[i] = run; qv[i] = bf2f(qraw[i]); kx[i] = 1.0f - __expf(lf[i]); }
        TOT[tq * 128 + k] = run;
        { const unsigned vv[8] = {va.x, va.y, va.z, va.w, vb.x, vb.y, vb.z, vb.w};
#pragma unroll
          for (int e = 0; e < 8; ++e) { VT[(wave * 16 + 2 * e) * 72 + lane] = (bf16)(vv[e] & 0xffffu); VT[(wave * 16 + 2 * e + 1) * 72 + lane] = (bf16)(vv[e] >> 16); } }
        __syncthreads();
        float off = 0.f;
#pragma unroll
        for (int q = 0; q < 4; ++q) { const float t = TOT[q * 128 + k]; off += (q < tq) ? t : 0.f; }
        const float mref = TOT[k] + TOT[128 + k];
#pragma unroll
        for (int i = 0; i < 16; ++i) { const float bc = off + cs[i]; const int o = (tq * 16 + i) * 136 + k;
            QH[o] = f2bf(qv[i] * __expf(bc)); QT[o] = f2bf(qv[i] * __expf(fminf(bc - mref, 80.f))); KL[o] = f2bf(kx[i] * __expf(fminf(mref - bc, 80.f))); }
        __syncthreads();
        if (item + G < 4096) HO_LOAD(item + G);
        {
            bf16x8 a[4];
#pragma unroll
            for (int kk = 0; kk < 4; ++kk) a[kk] = *(const LAS bf16x8*)(QT + (16 * mt + fr) * 136 + 32 * kk + 8 * fq);
#pragma unroll
            for (int q = 0; q < 2; ++q) { const int nt = (wave & 1) * 2 + q; f32x4 c = {0.f, 0.f, 0.f, 0.f};
#pragma unroll
                for (int kk = 0; kk < 4; ++kk) { const bf16x8 bb = *(const LAS bf16x8*)(KL + (16 * nt + fr) * 136 + 32 * kk + 8 * fq); c = __builtin_amdgcn_mfma_f32_16x16x32_bf16(a[kk], bb, c, 0, 0, 0); }
#pragma unroll
                for (int r = 0; r < 4; ++r) { const int t = 16 * mt + 4 * fq + r, s = 16 * nt + fr; ATT[t * 72 + s] = (s <= t) ? f2bf(c[r]) : (bf16)0; } }
        }
        __syncthreads();
        {
            bf16x8 aA[2], aQ[4];
#pragma unroll
            for (int kk = 0; kk < 2; ++kk) aA[kk] = *(const LAS bf16x8*)(ATT + (16 * mt + fr) * 72 + 32 * kk + 8 * fq);
#pragma unroll
            for (int kk = 0; kk < 4; ++kk) aQ[kk] = *(const LAS bf16x8*)(QH + (16 * mt + fr) * 136 + 32 * kk + 8 * fq);
#pragma unroll
            for (int q = 0; q < 4; ++q) { const int nt = (wave & 1) * 4 + q; f32x4 c = {0.f, 0.f, 0.f, 0.f};
#pragma unroll
                for (int kk = 0; kk < 2; ++kk) { const bf16x8 bb = *(const LAS bf16x8*)(VT + (16 * nt + fr) * 72 + 32 * kk + 8 * fq); c = __builtin_amdgcn_mfma_f32_16x16x32_bf16(aA[kk], bb, c, 0, 0, 0); }
#pragma unroll
                for (int kk = 0; kk < 4; ++kk) c = __builtin_amdgcn_mfma_f32_16x16x32_bf16(aQ[kk], sfrag[q][kk], c, 0, 0, 0);
#pragma unroll
                for (int r = 0; r < 4; ++r) OB[(16 * mt + 4 * fq + r) * 132 + 16 * nt + fr] = c[r]; }
        }
        __syncthreads();
        {
            f32x4 o[4]; float ss = 0.f;
#pragma unroll
            for (int i = 0; i < 4; ++i) { o[i] = *(const LAS f32x4*)(OB + t_n * 132 + cg8 * 16 + 4 * i); ss += (o[i][0] * o[i][0] + o[i][1] * o[i][1]) + (o[i][2] * o[i][2] + o[i][3] * o[i][3]); }
            ss += __shfl_xor(ss, 1); ss += __shfl_xor(ss, 2); ss += __shfl_xor(ss, 4);
            const float rs = __builtin_amdgcn_rsqf(ss * (1.0f / 128.0f) + 1e-6f);
            const unsigned gg[8] = {g0.x, g0.y, g0.z, g0.w, g1.x, g1.y, g1.z, g1.w};
            unsigned w[8];
#pragma unroll
            for (int i = 0; i < 4; ++i) { const f32x4 og = *(const f32x4*)(onorm + cg8 * 16 + 4 * i);
                w[2 * i] = pk2(o[i][0] * rs * og[0] * bf_lo(gg[2 * i]), o[i][1] * rs * og[1] * bf_hi(gg[2 * i]));
                w[2 * i + 1] = pk2(o[i][2] * rs * og[2] * bf_lo(gg[2 * i + 1]), o[i][3] * rs * og[3] * bf_hi(gg[2 * i + 1])); }
            *(v4u*)(QA + goff) = (v4u){w[0], w[1], w[2], w[3]}; *(v4u*)(QA + goff + 8) = (v4u){w[4], w[5], w[6], w[7]};
        }
        __syncthreads();
    }
#undef HO_LOAD
}

#define XB_TMO      128
#define XB_XCNT(j)  (256  + 64 * (j))
#define XB_XSUB(j)  (1280 + 64 * (j))
#define XB_XGEN(j)  (2304 + 64 * (j))
#define XB_TOP      3328
#define XB_TOPGEN   3392
#define XCD_BAR_WORDS 3456
#define XB_SPIN_CAP (1u << 18)

__device__ __forceinline__ unsigned xb_ld(unsigned* p)              { return __hip_atomic_load(p, __ATOMIC_RELAXED, __HIP_MEMORY_SCOPE_AGENT); }
__device__ __forceinline__ unsigned xb_add(unsigned* p, unsigned v) { return __hip_atomic_fetch_add(p, v, __ATOMIC_RELAXED, __HIP_MEMORY_SCOPE_AGENT); }
__device__ __forceinline__ unsigned xb_xcc_id() { return (unsigned)__builtin_amdgcn_s_getreg((3 << 11) | 20) & 0xFu; }
#define XB_SPIN(cond, bar) do { unsigned _sp = 0; while (cond) { __builtin_amdgcn_s_sleep(1); \
    if ((++_sp & 255u) == 0u) { if (xb_ld(&(bar)[XB_TMO])) break; if (_sp > XB_SPIN_CAP) { atomicAdd(&(bar)[XB_TMO], 1u); break; } } } } while (0)

struct XcdBarrier {
    unsigned* bar; unsigned x;
    volatile LAS unsigned* st;
};

__device__ __forceinline__ XcdBarrier xcd_barrier_post(unsigned* bar, volatile LAS unsigned* st) {
    XcdBarrier b; b.bar = bar; b.x = xb_xcc_id(); b.st = st;
    if (threadIdx.x == 0) (void)xb_add(&bar[XB_XCNT(b.x)], 1u);
    return b;
}
__device__ __forceinline__ void xcd_barrier_complete(unsigned* bar, unsigned x, unsigned& nloc, unsigned& nx) {
    const unsigned G = gridDim.x * gridDim.y * gridDim.z;
    unsigned sum, cnt, mine, sp = 0u;
    for (;;) {
        sum = 0u; cnt = 0u; mine = 0u;
#pragma unroll
        for (unsigned j = 0; j < 16; ++j) { const unsigned c = xb_ld(&bar[XB_XCNT(j)]); sum += c; cnt += (c > 0u) ? 1u : 0u; mine = (j == x) ? c : mine; }
        if (sum == G) break;
        __builtin_amdgcn_s_sleep(1);
        if ((++sp & 255u) == 0u) { if (xb_ld(&bar[XB_TMO])) break; if (sp > XB_SPIN_CAP) { atomicAdd(&bar[XB_TMO], 1u); break; } }
    }
    nloc = mine > 0u ? mine : 1u; nx = cnt > 0u ? cnt : 1u;
}

__device__ __forceinline__ void xcd_barrier(const XcdBarrier& b) {
    asm volatile("s_waitcnt vmcnt(0)" ::: "memory");
    __syncthreads();
    if (threadIdx.x == 0) {
        unsigned* bar = b.bar;
        __builtin_amdgcn_s_waitcnt(0);
        unsigned nloc = b.st[0], nx = b.st[1];
        if (nloc == 0u) { xcd_barrier_complete(bar, b.x, nloc, nx); b.st[0] = nloc; b.st[1] = nx; }
        const unsigned old = xb_add(&bar[XB_XSUB(b.x)], 1u);
        const unsigned gen = old / nloc;
        if (old + 1u == (gen + 1u) * nloc) {
            __builtin_amdgcn_fence(__ATOMIC_RELEASE, "agent");
            asm volatile("s_waitcnt vmcnt(0)" ::: "memory");
            const unsigned og = xb_add(&bar[XB_TOP], 1u);
            const unsigned tg = og / nx;
            if (og + 1u == (tg + 1u) * nx) xb_add(&bar[XB_TOPGEN], 1u);
            else XB_SPIN(xb_ld(&bar[XB_TOPGEN]) == tg, bar);
            __builtin_amdgcn_fence(__ATOMIC_ACQUIRE, "agent");
            xb_add(&bar[XB_XGEN(b.x)], 1u);
            asm volatile("s_waitcnt vmcnt(0)" ::: "memory");
        } else {
            XB_SPIN(xb_ld(&bar[XB_XGEN(b.x)]) == gen, bar);
            __builtin_amdgcn_fence(__ATOMIC_ACQUIRE, "agent");
            asm volatile("s_waitcnt vmcnt(0)" ::: "memory");
        }
    }
    __syncthreads();
}

constexpr size_t WS_BAR = 7 * MiB;
struct Args { const void* in[20]; float* out; unsigned char* ws; };
constexpr int MISC_OFF = 131072, LDS_BYTES = 131072 + 256 + 11 * 512 * 4;

__global__ void __launch_bounds__(512) mega_fwd(Args a) {
    extern __shared__ __attribute__((aligned(16))) unsigned char lds[];
    cg::grid_group grid = cg::this_grid();
    LAS unsigned char* L = (LAS unsigned char*)lds;
    const int G = gridDim.x, blk = blockIdx.x;
    if (threadIdx.x < 64) ((LAS unsigned*)(L + MISC_OFF))[threadIdx.x] = 0u;
    __syncthreads();
#define TIDS() const int tid = opaque_tid(), lane = tid & 63, wave = __builtin_amdgcn_readfirstlane(tid >> 6), gw = blk * 8 + wave, NGW = G * 8; (void)lane; (void)gw; (void)NGW
    typedef __attribute__((address_space(4))) const Args CArgs;
    const CArgs* const ap0 = (const CArgs*)__builtin_amdgcn_kernarg_segment_ptr();
#define ARGS() ({ const CArgs* p_ = ap0; asm volatile("" : "+s"(p_)); p_; })
#define CG_SYNC() do { asm volatile("s_waitcnt vmcnt(0) lgkmcnt(0)" ::: "memory"); grid.sync(); __builtin_amdgcn_fence(__ATOMIC_ACQUIRE, "agent"); asm volatile("s_waitcnt vmcnt(0)" ::: "memory"); } while (0)
#define XBAR_MAKE() XcdBarrier b_; b_.bar = (unsigned*)(ARGS()->ws + WS_BAR); b_.x = xb_xcc_id(); b_.st = (volatile LAS unsigned*)(L + MISC_OFF)
#ifdef DUP_SYNC
#define GRID_SYNC() do { XBAR_MAKE(); xcd_barrier(b_); xcd_barrier(b_); } while (0)
#else
#define GRID_SYNC() do { XBAR_MAKE(); xcd_barrier(b_); } while (0)
#endif
#define IN_F(k) ((const float*)ap->in[k])
#define WSP(off) (ap->ws + (off))
#ifndef P0REP
#define P0REP 1
#endif
    for (int rep_ = 0; rep_ < P0REP; ++rep_)
    {
        const CArgs* ap = ARGS(); TIDS();
        const float* c_in = IN_F(1); const float* ada_w = IN_F(3); const float* ada_b = IN_F(4); float* MOD = (float*)WSP(WS_MOD);
        LAS float* CA = (LAS float*)L; LAS float* PS = (LAS float*)(L + 16384);
        for (int i = tid; i < 4096; i += 512) { const float v = c_in[i]; CA[i] = pg8::silu_f(v); }
        if (blk == 0) for (int i = tid; i < XCD_BAR_WORDS; i += 512) ((unsigned*)WSP(WS_BAR))[i] = 0u;
        __syncthreads();
        for (int it = blk; it < 576; it += G) {
            const int l = it / 144, n0 = (it % 144) * 64;
            const float* wp = ada_w + ((size_t)l * 1024 + wave * 128) * 9216 + n0 + lane;
            float s0 = 0.f, s1 = 0.f, s2 = 0.f, s3 = 0.f;
#pragma unroll 16
            for (int kk = 0; kk < 128; ++kk) { const float w = __builtin_nontemporal_load(wp + (size_t)kk * 9216); const int k = wave * 128 + kk;
                s0 += CA[k] * w; s1 += CA[1024 + k] * w; s2 += CA[2048 + k] * w; s3 += CA[3072 + k] * w; }
            PS[(wave * 4 + 0) * 64 + lane] = s0; PS[(wave * 4 + 1) * 64 + lane] = s1; PS[(wave * 4 + 2) * 64 + lane] = s2; PS[(wave * 4 + 3) * 64 + lane] = s3;
            __syncthreads();
            if (tid < 256) { const int b = tid >> 6, n = tid & 63; float s = ada_b[l * 9216 + n0 + n];
#pragma unroll
                for (int w = 0; w < 8; ++w) s += PS[(w * 4 + b) * 64 + n];
                MOD[(size_t)(l * 4 + b) * 9216 + n0 + n] = s; }
            __syncthreads();
        }
        const int* positions = (const int*)ap->in[2]; float* ROPE = (float*)WSP(WS_ROPE);
        for (int e = blk * 512 + tid; e < 32768 * 8; e += G * 512) {
            const int row = e >> 3, j = e & 7;
            const float invf = j == 0 ? 1.0f : j == 1 ? 0.19392274474868576f : j == 2 ? 0.03760603093086393f : j == 3 ? 0.007292664737217109f : j == 4 ? 0.001414213562373095f : j == 5 ? 0.0002742481756762073f : j == 6 ? 5.318295896944988e-05f : 1.031338537721246e-05f;
            const float ang = (float)positions[row] * invf;
            const double rev = (double)ang * 0.15915494309189535; const float fr_ = (float)(rev - __builtin_rint(rev));
            ROPE[(size_t)row * 16 + j] = __builtin_amdgcn_cosf(fr_); ROPE[(size_t)row * 16 + 8 + j] = __builtin_amdgcn_sinf(fr_);
        }
        LAS float* scr = (LAS float*)(L + wave * 16384);
        for (int it0 = gw; it0 < 43008; it0 += NGW) {
            int it = it0; ap = ARGS();
            const float* ffn_wi = IN_F(6); const float* ffn_wo = IN_F(7); const float* a_w_in = IN_F(8); const float* a_w_out = IN_F(9); const float* b_w_in = IN_F(12); const float* b_w_out = IN_F(13); const float* c_w_in = IN_F(17); const float* c_w_out = IN_F(19);
            bf16* WI = (bf16*)WSP(WS_WI); bf16* WO = (bf16*)WSP(WS_WO); bf16* AIN = (bf16*)WSP(WS_AIN); bf16* AOUT = (bf16*)WSP(WS_AOUT); bf16* BIN = (bf16*)WSP(WS_BIN); bf16* BOUT = (bf16*)WSP(WS_BOUT); bf16* CIN = (bf16*)WSP(WS_CIN); bf16* COUT = (bf16*)WSP(WS_COUT);
            if (it < 22528) { const int mat = it / 2816, r = it % 2816, kb = r / 176, n0 = (r % 176) * 32; const int src = ((n0 & 255) >> 7) * 2816 + (n0 >> 8) * 128 + (n0 & 127);
                tr_item(ffn_wi + (size_t)mat * 1024 * 5632, 1024, 5632, WI + (size_t)mat * 5632 * 1024, kb * 64, n0, src, scr, lane); continue; } it -= 22528;
            if (it < 11264) { const int mat = it / 1408, r = it % 1408, kb = r / 32, n0 = (r % 32) * 32;
                tr_item(ffn_wo + (size_t)mat * 2816 * 1024, 2816, 1024, WO + (size_t)mat * 1024 * 2816, kb * 64, n0, n0, scr, lane); continue; } it -= 11264;
            if (it < 4096) { const int mat = it / 2048, r = it % 2048, kb = r / 128, n0 = (r % 128) * 32;
                tr_item(a_w_in + (size_t)mat * 1024 * 4096, 1024, 4096, AIN + (size_t)mat * 4096 * 1024, kb * 64, n0, n0, scr, lane); continue; } it -= 4096;
            if (it < 1024) { const int mat = it / 512, r = it % 512, kb = r / 32, n0 = (r % 32) * 32;
                tr_item(a_w_out + (size_t)mat * 1024 * 1024, 1024, 1024, AOUT + (size_t)mat * 1024 * 1024, kb * 64, n0, n0, scr, lane); continue; } it -= 1024;
            if (it < 1536) { const int kb = it / 96, n0 = (it % 96) * 32; const int src = n0 < 2048 ? (n0 >> 8) * 256 + ((n0 & 127) >> 5) * 64 + ((n0 & 255) >> 7) * 32 : n0;
                tr_item(b_w_in, 1024, 3072, BIN, kb * 64, n0, src, scr, lane); continue; } it -= 1536;
            if (it < 512) { const int kb = it / 32, n0 = (it % 32) * 32; tr_item(b_w_out, 1024, 1024, BOUT, kb * 64, n0, n0, scr, lane); continue; } it -= 512;
            if (it < 1536) { const int kb = it / 96, n0 = (it % 96) * 32; const int src = n0 < 2048 ? 1024 + ((n0 & 255) >> 7) * 1024 + (n0 >> 8) * 128 + (n0 & 127) : n0 - 2048;
                tr_item(c_w_in, 1024, 3072, CIN, kb * 64, n0, src, scr, lane); continue; } it -= 1536;
            { const int kb = it / 32, n0 = (it % 32) * 32; tr_item(c_w_out, 1024, 1024, COUT, kb * 64, n0, n0, scr, lane); }
        }
        __syncthreads();
    }
    CG_SYNC();
    (void)xcd_barrier_post((unsigned*)(ARGS()->ws + WS_BAR), (volatile LAS unsigned*)(L + MISC_OFF));
    {
        const CArgs* ap = ARGS(); TIDS();
        const float* x_in = IN_F(0); const float* norm_g = IN_F(5); float* MOD = (float*)WSP(WS_MOD); float* BIAS = (float*)WSP(WS_BIAS); float* SSQ = (float*)WSP(WS_SSQP); bf16* XG = (bf16*)WSP(WS_XG);
        bf16* WI = (bf16*)WSP(WS_WI); bf16* AIN = (bf16*)WSP(WS_AIN); bf16* BIN = (bf16*)WSP(WS_BIN); bf16* CIN = (bf16*)WSP(WS_CIN);
        for (int slot = gw; slot < 12 * 88; slot += NGW) {
            const int sl = slot / 88, ng = slot % 88, l = sl / 3, j = sl % 3, kind = l % 3, idx = l / 3;
            const bf16* Wt; int N;
            if (j != 1) { Wt = WI + (size_t)(l * 2 + (j >> 1)) * 5632 * 1024; N = 5632; }
            else if (kind == 0) { Wt = AIN + (size_t)idx * 4096 * 1024; N = 4096; }
            else if (kind == 1) { Wt = BIN; N = 3072; }
            else { Wt = CIN; N = 3072; }
            if (ng * 64 >= N) continue;
            f32x4 sh[4][4];
#pragma unroll
            for (int b = 0; b < 4; ++b)
#pragma unroll
                for (int i = 0; i < 4; ++i) sh[b][i] = *(const f32x4*)(MOD + (size_t)(l * 4 + b) * 9216 + (j * 3) * 1024 + lane * 16 + 4 * i);
            float res0 = 0.f, res1 = 0.f, res2 = 0.f, res3 = 0.f;
            for (int nn = 0; nn < 64; ++nn) {
                const bf16* wr_ = Wt + (size_t)(ng * 64 + nn) * 1024 + lane * 16;
                const v4u w0 = *(const v4u*)wr_, w1 = *(const v4u*)(wr_ + 8);
                const unsigned ww[8] = {w0.x, w0.y, w0.z, w0.w, w1.x, w1.y, w1.z, w1.w};
                float d[4] = {0.f, 0.f, 0.f, 0.f};
#pragma unroll
                for (int i = 0; i < 4; ++i) { const float e0 = bf_lo(ww[2 * i]), e1 = bf_hi(ww[2 * i]), e2 = bf_lo(ww[2 * i + 1]), e3 = bf_hi(ww[2 * i + 1]);
#pragma unroll
                    for (int b = 0; b < 4; ++b) d[b] += (e0 * sh[b][i][0] + e1 * sh[b][i][1]) + (e2 * sh[b][i][2] + e3 * sh[b][i][3]); }
                const float t0 = wave_sum(d[0]), t1 = wave_sum(d[1]), t2 = wave_sum(d[2]), t3 = wave_sum(d[3]);
                if (lane == nn) { res0 = t0; res1 = t1; res2 = t2; res3 = t3; }
            }
            float* bp = BIAS + (size_t)sl * 4 * 5632 + ng * 64 + lane;
            bp[0] = res0; bp[5632] = res1; bp[2 * 5632] = res2; bp[3 * 5632] = res3;
        }
        for (int row = gw; row < M_ROWS; row += NGW) {
            const int b = row >> 13; const f32x4* xr = (const f32x4*)(x_in + (size_t)row * 1024) + lane;
            f32x4 v[4]; float s = 0.f;
#pragma unroll
            for (int jj = 0; jj < 4; ++jj) { v[jj] = __builtin_nontemporal_load(xr + 64 * jj); s += (v[jj][0] * v[jj][0] + v[jj][1] * v[jj][1]) + (v[jj][2] * v[jj][2] + v[jj][3] * v[jj][3]); }
            s = wave_sum(s); if (lane < 16) SSQ[(size_t)row * 16 + lane] = lane == 0 ? s : 0.f;
#pragma unroll
            for (int jj = 0; jj < 4; ++jj) { const int k = 256 * jj + 4 * lane; const f32x4 g = *(const f32x4*)(norm_g + k) * (*(const f32x4*)(MOD + (size_t)b * 9216 + 1024 + k) + 1.0f); const f32x4 y = v[jj] * g;
                *(v2u*)(XG + (size_t)row * 1024 + k) = (v2u){pk2(y[0], y[1]), pk2(y[2], y[3])}; }
        }
    }
    GRID_SYNC();

#ifndef PG8_ALIGN_EPI
#define PG8_ALIGN_EPI true
#endif
#ifndef PG8_SP2
#define PG8_SP2 true
#endif
#define GEMM_CALL(EpiT, E, Aptr, Btptr, N_, K_) do { const pg8::Gemm g_{(const pg8::bf16_t*)(Aptr), (const pg8::bf16_t*)(Btptr), M_ROWS, (N_), (K_)}; pg8::StaticOrder S_; S_.init(M_ROWS, (N_), G, blk); \
        pg8::gemm_phase<EpiT, pg8::StaticOrder, PG8_ALIGN_EPI, PG8_SP2>(L, g_, S_, E); } while (0)

#ifndef NSUB
#define NSUB 12
#endif
    for (int sl = 0; sl < NSUB; ++sl) {
        const int l = sl / 3, j = sl % 3, kind = l % 3, idx = l / 3;
        const CArgs* ap = ARGS();
        unsigned char* SCR = WSP(WS_SCR); bf16* XG = (bf16*)WSP(WS_XG);
        const float* ssq_cur = (const float*)WSP(WS_SSQP) + (size_t)(sl & 1) * 32768 * 16; const float* bias_cur = (const float*)WSP(WS_BIAS) + (size_t)sl * 4 * 5632;
        const bf16* Amix; const bf16* Wout; int Kout;
        if (j != 1) {
            bf16* HID = (bf16*)SCR;
#ifdef DUP_SWIGLU
            for (int rep_ = 0; rep_ < 2; ++rep_) {
            { LAS float* el = (LAS float*)(L + pg8::EPI_LDS_OFF); { pg8::StaticOrder S0; S0.init(M_ROWS, 5632, G, blk); const int t0_ = opaque_tid(); pg8::stage_swiglu(el, S0, ssq_cur, bias_cur, __builtin_amdgcn_readfirstlane(t0_ >> 6), t0_ & 63); } __syncthreads();
              const pg8::EpiSwiGLU E{HID, el}; GEMM_CALL(pg8::EpiSwiGLU, E, XG, (const bf16*)WSP(WS_WI) + (size_t)(l * 2 + (j >> 1)) * 5632 * 1024, 5632, rep_ == 0 ? DUP_K : 1024); }
            GRID_SYNC(); ap = ARGS(); }
#else
            { LAS float* el = (LAS float*)(L + pg8::EPI_LDS_OFF);
              { pg8::StaticOrder S0; S0.init(M_ROWS, 5632, G, blk); const int t0_ = opaque_tid(); pg8::stage_swiglu(el, S0, ssq_cur, bias_cur, __builtin_amdgcn_readfirstlane(t0_ >> 6), t0_ & 63); }
              __syncthreads();
              const pg8::EpiSwiGLU E{HID, el}; GEMM_CALL(pg8::EpiSwiGLU, E, XG, (const bf16*)WSP(WS_WI) + (size_t)(l * 2 + (j >> 1)) * 5632 * 1024, 5632, 1024); }
            GRID_SYNC();
#endif
            ap = ARGS(); Amix = (const bf16*)WSP(WS_SCR); Wout = (const bf16*)WSP(WS_WO) + (size_t)(l * 2 + (j >> 1)) * 1024 * 2816; Kout = 2816;
        } else if (kind == 0) {
            bf16* Qb = (bf16*)SCR; bf16* Vb = (bf16*)(SCR + ACT); bf16* Gb = (bf16*)(SCR + 2 * ACT); float* LOGF = (float*)(SCR + 3 * ACT); bf16* SLOC = (bf16*)(SCR + 5 * ACT); float* DEC = (float*)(SCR + 7 * ACT);
            { const pg8::EpiHgrnIn E{Qb, LOGF, ssq_cur, bias_cur, IN_F(10), idx}; GEMM_CALL(pg8::EpiHgrnIn, E, XG, (const bf16*)WSP(WS_AIN) + (size_t)idx * 4096 * 1024, 4096, 1024); }
            GRID_SYNC();
#if !defined(NO_HGRN) && !defined(NO_HL)
            hgrn_local(L, LOGF, Vb, SLOC, DEC, blk, G, opaque_tid());
#endif
#ifdef DUP_HL
            hgrn_local(L, LOGF, Vb, SLOC, DEC, blk, G, opaque_tid());
#endif
            GRID_SYNC();
#if !defined(NO_HGRN) && !defined(NO_HS)
            hgrn_scan(SLOC, DEC, blk, G, opaque_tid());
#endif
            GRID_SYNC();
#if !defined(NO_HGRN) && !defined(NO_HO)
            hgrn_out(L, LOGF, Qb, Vb, Gb, SLOC, IN_F(11) + idx * 128, blk, G, opaque_tid());
#endif
            GRID_SYNC();
            ap = ARGS(); Amix = (const bf16*)WSP(WS_SCR); Wout = (const bf16*)WSP(WS_AOUT) + (size_t)idx * 1024 * 1024; Kout = 1024;
        } else if (kind == 1) {
            bf16* Qb = (bf16*)SCR; bf16* Kb = (bf16*)(SCR + ACT); bf16* Vb = (bf16*)(SCR + 2 * ACT); bf16* O0 = (bf16*)(SCR + 3 * ACT); bf16* O1 = (bf16*)(SCR + 4 * ACT); bf16* Am = (bf16*)(SCR + 5 * ACT);
            { const pg8::EpiAttnIn E{Qb, ssq_cur, bias_cur, IN_F(14), (const float*)WSP(WS_ROPE)}; GEMM_CALL(pg8::EpiAttnIn, E, XG, (const bf16*)WSP(WS_BIN), 3072, 1024); }
            GRID_SYNC();
            { const attn_body::AttnTensors AT{(const attn_body::bf16*)Qb, (const attn_body::bf16*)Kb, (const attn_body::bf16*)Vb, (attn_body::bf16*)O0, (attn_body::bf16*)O1};
              const attn_body::DiffOrder S((int)G, (int)blk);
#ifndef NO_ATTN
              attn_body::attn_phase<8>((char*)lds, AT, S);
#endif
#ifdef DUP_ATTN
              attn_body::attn_phase<8>((char*)lds, AT, S);
#endif
            }
            GRID_SYNC();
            {   TIDS();
                const float lambda_init = 0.35550906759096934f; const float* b_lam = IN_F(15); const float* b_subln = IN_F(16);
                const float s1 = wave_sum(b_lam[lane] * b_lam[64 + lane]), s2 = wave_sum(b_lam[128 + lane] * b_lam[192 + lane]);
                const float lam = __expf(s1) - __expf(s2) + lambda_init;
                const int c0 = lane * 16;
                f32x4 sg[4];
#pragma unroll
                for (int i = 0; i < 4; ++i) sg[i] = *(const f32x4*)(b_subln + (c0 & 127) + 4 * i) * (1.0f - lambda_init);
                for (int row = gw; row < M_ROWS; row += NGW) {
                    const size_t off = (size_t)row * 1024 + c0;
                    const v4u p0 = *(const v4u*)(O0 + off), p1 = *(const v4u*)(O0 + off + 8), q0 = *(const v4u*)(O1 + off), q1 = *(const v4u*)(O1 + off + 8);
                    const unsigned pa[8] = {p0.x, p0.y, p0.z, p0.w, p1.x, p1.y, p1.z, p1.w}, qa[8] = {q0.x, q0.y, q0.z, q0.w, q1.x, q1.y, q1.z, q1.w};
                    float v[16]; float ss = 0.f;
#pragma unroll
                    for (int i = 0; i < 8; ++i) { v[2 * i] = bf_lo(pa[i]) - lam * bf_lo(qa[i]); v[2 * i + 1] = bf_hi(pa[i]) - lam * bf_hi(qa[i]); ss += v[2 * i] * v[2 * i] + v[2 * i + 1] * v[2 * i + 1]; }
                    ss += __shfl_xor(ss, 1); ss += __shfl_xor(ss, 2); ss += __shfl_xor(ss, 4);
                    const float rs = __builtin_amdgcn_rsqf(ss * (1.0f / 128.0f) + 1e-6f);
                    unsigned w[8];
#pragma unroll
                    for (int i = 0; i < 8; ++i) w[i] = pk2(v[2 * i] * rs * sg[i >> 1][(2 * i) & 3], v[2 * i + 1] * rs * sg[i >> 1][(2 * i + 1) & 3]);
                    *(v4u*)(Am + off) = (v4u){w[0], w[1], w[2], w[3]}; *(v4u*)(Am + off + 8) = (v4u){w[4], w[5], w[6], w[7]};
                }
            }
            GRID_SYNC();
            ap = ARGS(); Amix = (const bf16*)(WSP(WS_SCR) + 5 * ACT); Wout = (const bf16*)WSP(WS_BOUT); Kout = 1024;
        } else {
            bf16* BGb = (bf16*)SCR; bf16* U2 = (bf16*)(SCR + ACT); bf16* Am = (bf16*)(SCR + 2 * ACT);
            { const pg8::EpiConvIn E{BGb, U2, ssq_cur, bias_cur}; GEMM_CALL(pg8::EpiConvIn, E, XG, (const bf16*)WSP(WS_CIN), 3072, 1024); }
            GRID_SYNC();
#ifndef NO_CONVEL
            {   TIDS();
                const int c0 = lane * 16; const float* c_conv = IN_F(18);
                f32x4 w0[4], w1[4], w2[4];
#pragma unroll
                for (int i = 0; i < 4; ++i) { w0[i] = *(const f32x4*)(c_conv + c0 + 4 * i); w1[i] = *(const f32x4*)(c_conv + 1024 + c0 + 4 * i); w2[i] = *(const f32x4*)(c_conv + 2048 + c0 + 4 * i); }
#ifdef CONV_LOCAL
                for (int ri = 0; ri < 16; ++ri) { const int row = (blk & 7) * 4096 + (blk >> 3) * 8 + wave + 256 * ri;
#else
                for (int row = gw; row < M_ROWS; row += NGW) {
#endif
                    const int t = row & 8191; const size_t off = (size_t)row * 1024 + c0;
                    const v4u z = {0u, 0u, 0u, 0u};
                    const v4u a0 = *(const v4u*)(U2 + off), a1 = *(const v4u*)(U2 + off + 8);
#ifdef CONV_NONEIGH
                    const v4u b0 = z, b1 = z, d0 = z, d1 = z; (void)t;
#else
                    const v4u b0 = t >= 1 ? *(const v4u*)(U2 + off - 1024) : z, b1 = t >= 1 ? *(const v4u*)(U2 + off - 1024 + 8) : z;
                    const v4u d0 = t >= 2 ? *(const v4u*)(U2 + off - 2048) : z, d1 = t >= 2 ? *(const v4u*)(U2 + off - 2048 + 8) : z;
#endif
                    const v4u g0 = *(const v4u*)(BGb + off), g1 = *(const v4u*)(BGb + off + 8);
                    const unsigned ua[8] = {a0.x, a0.y, a0.z, a0.w, a1.x, a1.y, a1.z, a1.w}, ub[8] = {b0.x, b0.y, b0.z, b0.w, b1.x, b1.y, b1.z, b1.w}, ud[8] = {d0.x, d0.y, d0.z, d0.w, d1.x, d1.y, d1.z, d1.w}, ug[8] = {g0.x, g0.y, g0.z, g0.w, g1.x, g1.y, g1.z, g1.w};
                    unsigned w[8];
#pragma unroll
                    for (int i = 0; i < 8; ++i) { const int q = i >> 1, e = (2 * i) & 3;
                        const float y0 = w0[q][e] * bf_lo(ud[i]) + w1[q][e] * bf_lo(ub[i]) + w2[q][e] * bf_lo(ua[i]), y1 = w0[q][e + 1] * bf_hi(ud[i]) + w1[q][e + 1] * bf_hi(ub[i]) + w2[q][e + 1] * bf_hi(ua[i]);
#if defined(CONV_T1)
                        w[i] = ug[i]; (void)y0; (void)y1;
#elif defined(CONV_T2)
                        w[i] = ua[i]; (void)y0; (void)y1;
#elif defined(CONV_T3)
                        w[i] = ((const unsigned*)(XG + off))[i]; (void)y0; (void)y1;
#else
                        w[i] = pk2(bf_lo(ug[i]) * y0, bf_hi(ug[i]) * y1);
#endif
                    }
                    *(v4u*)(Am + off) = (v4u){w[0], w[1], w[2], w[3]}; *(v4u*)(Am + off + 8) = (v4u){w[4], w[5], w[6], w[7]};
                }
            }
#endif
            GRID_SYNC();
            ap = ARGS(); Amix = (const bf16*)(WSP(WS_SCR) + 2 * ACT); Wout = (const bf16*)WSP(WS_COUT); Kout = 1024;
        }
        {
            const bool has_next = sl < 11; const int sn = sl + 1, jn = sn % 3;
            float* out = ap->out; const float* x_in = IN_F(0); const float* norm_g = IN_F(5); float* MOD = (float*)WSP(WS_MOD); float* SSQ = (float*)WSP(WS_SSQP); bf16* XGn = (bf16*)WSP(WS_XG);
            const int snv = has_next ? sn : 0, lnv = snv / 3;
            const pg8::EpiRes E{x_in, out, XGn, SSQ + (size_t)(snv & 1) * 32768 * 16, MOD + (size_t)l * 36864 + (j * 3 + 2) * 1024,
                                norm_g + (size_t)sl * 1024, MOD + (size_t)l * 36864 + (j * 3 + 1) * 1024,
                                norm_g + (size_t)snv * 1024, MOD + (size_t)lnv * 36864 + (jn * 3 + 1) * 1024, j == 1 ? 1.0f : 0.5f, sl == 0 ? 0 : (has_next ? 1 : 2)};
            GEMM_CALL(pg8::EpiRes, E, Amix, Wout, 1024, Kout);
        }
        if (sl < NSUB - 1) GRID_SYNC();
    }
}

extern "C" void kernel_launch(void* const* d_in, const int* in_sizes, int n_in, void* d_out, int out_size, void* d_ws, size_t ws_size, hipStream_t stream) {
    static int grid = 0;
    if (grid == 0) {
        if (n_in != 20 || out_size != M_ROWS * DM || ws_size < WS_END) { fprintf(stderr, "kernel_launch: unexpected problem (n_in %d, out %d, ws %zu; need ws >= %zu)\n", n_in, out_size, ws_size, (size_t)WS_END); grid = -1; return; }
        int dev = 0, cus = 0, per_cu = 0;
        if (hipGetDevice(&dev) != hipSuccess || hipDeviceGetAttribute(&cus, hipDeviceAttributeMultiprocessorCount, dev) != hipSuccess) { grid = -1; return; }
        (void)hipFuncSetAttribute((const void*)mega_fwd, hipFuncAttributeMaxDynamicSharedMemorySize, LDS_BYTES);
        if (hipOccupancyMaxActiveBlocksPerMultiprocessor(&per_cu, (const void*)mega_fwd, 512, LDS_BYTES) != hipSuccess || per_cu < 1) { fprintf(stderr, "kernel_launch: occupancy query gave %d\n", per_cu); per_cu = 1; }
        (void)hipGetLastError();
        grid = cus * per_cu;
    }
    if (grid < 0) return;
    Args a{};
    for (int i = 0; i < 20; ++i) a.in[i] = d_in[i];
    a.out = (float*)d_out; a.ws = (unsigned char*)d_ws;
    void* args[] = {&a};
    const hipError_t e = hipLaunchCooperativeKernel((const void*)mega_fwd, dim3(grid), dim3(512), args, LDS_BYTES, stream);
    if (e != hipSuccess) fprintf(stderr, "kernel_launch: cooperative launch failed: %s (grid %d)\n", hipGetErrorString(e), grid);
}
```

```cpp
#include <hip/hip_runtime.h>
#include <hip/hip_cooperative_groups.h>
#include <cstdio>
#include <cstdint>
__device__ __forceinline__ int opaque_tid() { int t = (int)threadIdx.x; asm volatile("" : "+v"(t)); return t; }
__device__ __forceinline__ int opaque_i(int v) { asm volatile("" : "+s"(v)); return v; }
namespace pg8 {
#define PG8_LAS __attribute__((address_space(3)))
typedef unsigned short bf16_t;
typedef short bf16x8 __attribute__((ext_vector_type(8)));
typedef float f32x4 __attribute__((ext_vector_type(4)));
typedef unsigned u32x4 __attribute__((ext_vector_type(4)));
constexpr int BM = 256, BK = 64, HALF = 128, HTB = HALF * BK * 2  , STAGE_BYTES = 8 * HTB, NXCD = 8, WGM = 8;

__host__ __device__ __forceinline__ int lds_byte(int r, int c) { const int st = (r >> 4) * 2 + (c >> 5), rr = r & 15, cc = c & 31, ob = rr * 64 + cc * 2; return st * 1024 + (ob ^ (((ob >> 9) & 1) << 5)); }
__host__ __device__ __forceinline__ void stage_rc(int b, int& R, int& C) { const int st = b / 1024, sb = b % 1024, swz = sb ^ (((sb >> 9) & 1) << 5); R = (st >> 1) * 16 + swz / 64; C = (st & 1) * 32 + (swz % 64) / 2; }
__host__ __device__ __forceinline__ int perm32(int rho) { const int n = rho >> 4, i = rho & 15; return 8 * (i >> 2) + 4 * n + (i & 3); }

struct Unit { int pm, pn, ui; };
struct Gemm { const bf16_t* A; const bf16_t* Bt; int M, N, K; };

struct StaticOrder {
    int nM, nN, nwg, G, c;
    __host__ __device__ void init(int M, int N, int G_, int c_) { nM = M / BM; nN = N / BM; nwg = nM * nN; G = G_; c = c_; }
    __host__ __device__ bool next(int i, Unit& u) const {
        const long L = (long)i * G + c; if (L >= nwg) return false;
        int wgid = (int)L; { const int q = nwg / NXCD, r = nwg % NXCD, xcd = wgid % NXCD, off = wgid / NXCD; wgid = (xcd < r ? xcd * (q + 1) : r * (q + 1) + (xcd - r) * q) + off; }
        const int nig = WGM * nN, gid = wgid / nig, fm = gid * WGM, gsz = (nM - fm) < WGM ? (nM - fm) : WGM;
        u.pm = fm + ((wgid % nig) % gsz); u.pn = (wgid % nig) / gsz; u.ui = i; return true;
    }
    __device__ __forceinline__ void a_ready(const Unit&) const {}
    __device__ __forceinline__ void done(const Unit&) const {}
};

typedef float f32x2c_t __attribute__((ext_vector_type(2))); typedef __bf16 bf16x2c_t __attribute__((ext_vector_type(2)));
__device__ __forceinline__ unsigned cvt_pk_bf16(float lo, float hi) { f32x2c_t v = {lo, hi}; bf16x2c_t b = __builtin_convertvector(v, bf16x2c_t); return __builtin_bit_cast(unsigned, b); }
typedef float f32x2 __attribute__((ext_vector_type(2)));
constexpr float RMS_EPS = 1e-6f;
constexpr float LOG2E = 1.4426950408889634f;
__device__ __forceinline__ float sigmoid_f(float v) { return __builtin_amdgcn_rcpf(1.0f + __builtin_amdgcn_exp2f(-LOG2E * v)); }
__device__ __forceinline__ float silu_f(float v) { return v * sigmoid_f(v); }
__device__ __forceinline__ u32x4 pack8(f32x4 a, f32x4 b) { u32x4 w; w.x = cvt_pk_bf16(a[0], a[1]); w.y = cvt_pk_bf16(a[2], a[3]); w.z = cvt_pk_bf16(b[0], b[1]); w.w = cvt_pk_bf16(b[2], b[3]); return w; }
__device__ __forceinline__ float row_rstd(const float* ssq, int row) {
    const f32x4* p = (const f32x4*)(ssq + (size_t)row * 16); const f32x4 a = p[0], b = p[1], c = p[2], d = p[3];
    const float s = (((a[0] + a[1]) + (a[2] + a[3])) + ((b[0] + b[1]) + (b[2] + b[3]))) + (((c[0] + c[1]) + (c[2] + c[3])) + ((d[0] + d[1]) + (d[2] + d[3])));
    return __builtin_amdgcn_rsqf(s * (1.0f / 1024.0f) + RMS_EPS); }
__device__ __forceinline__ void row_rstd4(const float* ssq, int row0, int fq, float (&rs)[4]) {
    f32x4 p[4];
#pragma unroll
    for (int m = 0; m < 4; ++m) p[m] = *(const f32x4*)(ssq + (size_t)(row0 + m * 16) * 16 + 4 * fq);
#pragma unroll
    for (int m = 0; m < 4; ++m) { float t = (p[m][0] + p[m][1]) + (p[m][2] + p[m][3]); t += __shfl_xor(t, 16); t += __shfl_xor(t, 32); rs[m] = __builtin_amdgcn_rsqf(t * (1.0f / 1024.0f) + RMS_EPS); }
}
__device__ __forceinline__ void row_rstd8(const float* ssq, int row0, int fq, float (&rs)[2][4]) {
    f32x4 p[2][4];
#pragma unroll
    for (int ai = 0; ai < 2; ++ai)
#pragma unroll
        for (int m = 0; m < 4; ++m) p[ai][m] = *(const f32x4*)(ssq + (unsigned)((row0 + ai * 128 + m * 16) * 16 + 4 * fq));
#pragma unroll
    for (int ai = 0; ai < 2; ++ai)
#pragma unroll
        for (int m = 0; m < 4; ++m) { float t = (p[ai][m][0] + p[ai][m][1]) + (p[ai][m][2] + p[ai][m][3]); t += __shfl_xor(t, 16); t += __shfl_xor(t, 32); rs[ai][m] = __builtin_amdgcn_rsqf(t * (1.0f / 1024.0f) + RMS_EPS); }
}
constexpr int BIAS_LD = 5632;

constexpr int EPI_LDS_OFF = 131072 + 256, EPI_UNIT_FLOATS = 512, EPI_MAX_UNITS = 11;
struct EpiSwiGLU {
    static constexpr bool PERM = true, AFTER_DRAIN = false;
    bf16_t* H; PG8_LAS const float* el;
    __device__ __forceinline__ void operator()(const f32x4 (&acc)[2][2][4][2], const Unit& u, int wr, int wc, int fr, int fq) const {
        const int hcol = u.pn * 128 + wc * 32 + 8 * fq;
        PG8_LAS const float* eu = el + u.ui * EPI_UNIT_FLOATS;
        PG8_LAS const float* bp = eu + 256 + wc * 32 + 8 * fq;
        const f32x4 bg0 = *(PG8_LAS const f32x4*)(bp), bg1 = *(PG8_LAS const f32x4*)(bp + 4), bu0 = *(PG8_LAS const f32x4*)(bp + 128), bu1 = *(PG8_LAS const f32x4*)(bp + 132);
#pragma unroll
        for (int ai = 0; ai < 2; ++ai) {
#pragma unroll
            for (int m = 0; m < 4; ++m) {
                const int rl = ai * 128 + wr * 64 + m * 16 + fr, row = u.pm * 256 + rl; const float rs = eu[rl];
                const f32x4 g0 = acc[ai][0][m][0] * rs + bg0, g1 = acc[ai][0][m][1] * rs + bg1, u0 = acc[ai][1][m][0] * rs + bu0, u1 = acc[ai][1][m][1] * rs + bu1;
                f32x4 h0, h1;
#pragma unroll
                for (int i = 0; i < 4; ++i) { const float ea = 1.0f + __builtin_amdgcn_exp2f(fminf(-LOG2E * g0[i], 60.0f)), eb = 1.0f + __builtin_amdgcn_exp2f(fminf(-LOG2E * g1[i], 60.0f));
                    const float r = __builtin_amdgcn_rcpf(ea * eb); h0[i] = g0[i] * (r * eb) * u0[i]; h1[i] = g1[i] * (r * ea) * u1[i]; }
                *(u32x4*)(H + (unsigned)(row * 2816 + hcol)) = pack8(h0, h1);
            } }
    }
};
template <class Sched> __device__ __forceinline__ void stage_swiglu(PG8_LAS float* el, const Sched& S, const float* ssq, const float* bias, int wave, int lane) {
    for (int i = wave; i < EPI_MAX_UNITS; i += 8) { Unit u; if (!S.next(i, u)) break;
        f32x4 p[4][4];
#pragma unroll
        for (int r = 0; r < 4; ++r)
#pragma unroll
            for (int q = 0; q < 4; ++q) p[r][q] = *(const f32x4*)(ssq + (unsigned)((u.pm * 256 + lane + 64 * r) * 16 + 4 * q));
        const f32x4 bv = *(const f32x4*)(bias + (u.pm >> 5) * BIAS_LD + u.pn * 256 + 4 * lane);
#pragma unroll
        for (int r = 0; r < 4; ++r) { float t[4];
#pragma unroll
            for (int q = 0; q < 4; ++q) t[q] = (p[r][q][0] + p[r][q][1]) + (p[r][q][2] + p[r][q][3]);
            el[i * EPI_UNIT_FLOATS + lane + 64 * r] = __builtin_amdgcn_rsqf(((t[0] + t[1]) + (t[2] + t[3])) * (1.0f / 1024.0f) + RMS_EPS); }
        *(PG8_LAS f32x4*)(el + i * EPI_UNIT_FLOATS + 256 + 4 * lane) = bv; }
}

struct EpiRes {
    static constexpr bool PERM = true, AFTER_DRAIN = false;
    const float* xin; float* xout; bf16_t* xg; float* ssqn; const float* gatep; const float* ngc; const float* scc; const float* ngn; const float* scn; float coef; int mode;
    __device__ __forceinline__ void operator()(f32x4 (&acc)[2][2][4][2], const Unit& u, int wr, int wc, int fr, int fq) const {
        const int b = u.pm >> 5, col0 = u.pn * 256 + wc * 32 + 8 * fq;
        f32x4 gs[2][2], rg[2][2];
#pragma unroll
        for (int bj = 0; bj < 2; ++bj)
#pragma unroll
            for (int n = 0; n < 2; ++n) { const int c = col0 + 128 * bj + 4 * n;
                { const f32x4 gt = (*(const f32x4*)(gatep + b * 9216 + c) + 1.0f) * coef;
#pragma unroll
                  for (int ai = 0; ai < 2; ++ai)
#pragma unroll
                      for (int m = 0; m < 4; ++m) acc[ai][bj][m][n] = acc[ai][bj][m][n] * gt; }
                gs[bj][n] = *(const f32x4*)(ngn + c) * (*(const f32x4*)(scn + b * 9216 + c) + 1.0f);
                const f32x4 gc = *(const f32x4*)(ngc + c) * (*(const f32x4*)(scc + b * 9216 + c) + 1.0f);
#pragma unroll
                for (int i = 0; i < 4; ++i) rg[bj][n][i] = 1.0f / gc[i]; }
#pragma unroll
        for (int am = 0; am < 4; ++am) { const int ai = am >> 1;
            u32x4 xr[2][2];
            if (mode != 0) {
#pragma unroll
                for (int mm = 0; mm < 2; ++mm)
#pragma unroll
                    for (int bj = 0; bj < 2; ++bj) xr[mm][bj] = *(const u32x4*)(xg + (unsigned)((u.pm * 256 + ai * 128 + wr * 64 + ((am & 1) * 2 + mm) * 16 + fr) * 1024 + col0 + 128 * bj));
            }
#pragma unroll
            for (int mm = 0; mm < 2; ++mm) { const int m = (am & 1) * 2 + mm;
                const int row = u.pm * 256 + ai * 128 + wr * 64 + m * 16 + fr; float ss = 0.f;
#pragma unroll
                for (int bj = 0; bj < 2; ++bj) { const unsigned off = (unsigned)(row * 1024 + col0 + 128 * bj);
                    f32x4 x0, x1;
                    if (mode == 0) { x0 = *(const f32x4*)(xin + off); x1 = *(const f32x4*)(xin + off + 4); }
                    else { const u32x4 w = xr[mm][bj];
                        x0 = (f32x4){__uint_as_float(w.x << 16), __uint_as_float(w.x & 0xffff0000u), __uint_as_float(w.y << 16), __uint_as_float(w.y & 0xffff0000u)} * rg[bj][0];
                        x1 = (f32x4){__uint_as_float(w.z << 16), __uint_as_float(w.z & 0xffff0000u), __uint_as_float(w.w << 16), __uint_as_float(w.w & 0xffff0000u)} * rg[bj][1]; }
                    x0 = x0 + acc[ai][bj][m][0]; x1 = x1 + acc[ai][bj][m][1];
                    if (mode == 2) { __builtin_nontemporal_store(x0, (f32x4*)(xout + off)); __builtin_nontemporal_store(x1, (f32x4*)(xout + off + 4)); }
                    else { ss += (x0[0] * x0[0] + x0[1] * x0[1]) + (x0[2] * x0[2] + x0[3] * x0[3]) + (x1[0] * x1[0] + x1[1] * x1[1]) + (x1[2] * x1[2] + x1[3] * x1[3]);
                        *(u32x4*)(xg + off) = pack8(x0 * gs[bj][0], x1 * gs[bj][1]); } }
                if (mode != 2) { ss += __shfl_xor(ss, 16); ss += __shfl_xor(ss, 32); if (fq == 0) ssqn[(unsigned)(row * 16 + u.pn * 4 + wc)] = ss; }
            }
        }
    }
};

struct EpiHgrnIn {
    static constexpr bool PERM = true, AFTER_DRAIN = false;
    bf16_t* QVG; float* LOGF; const float* ssq; const float* bias; const float* a_lb; int idx;
    __device__ __forceinline__ void operator()(const f32x4 (&acc)[2][2][4][2], const Unit& u, int wr, int wc, int fr, int fq) const {
        float rsv8[2][4]; row_rstd8(ssq, u.pm * 256 + wr * 64 + fr, fq, rsv8);
        const int b = u.pm >> 5, type = u.pn >> 2, bcol = u.pn * 256 + wc * 32 + 8 * fq, cc = (u.pn & 3) * 256 + wc * 32 + 8 * fq;
        f32x4 bv[2][2], lb[2][2];
#pragma unroll
        for (int bj = 0; bj < 2; ++bj)
#pragma unroll
            for (int n = 0; n < 2; ++n) { bv[bj][n] = *(const f32x4*)(bias + b * BIAS_LD + bcol + 128 * bj + 4 * n); lb[bj][n] = (f32x4){0.f, 0.f, 0.f, 0.f};
                if (type == 1 && idx != 0) { const f32x4 a0 = *(const f32x4*)(a_lb + cc + 128 * bj + 4 * n), a1 = *(const f32x4*)(a_lb + 1024 + cc + 128 * bj + 4 * n);
#pragma unroll
                    for (int i = 0; i < 4; ++i) lb[bj][n][i] = sigmoid_f(a1[i] - a0[i]); } }
#pragma unroll
        for (int ai = 0; ai < 2; ++ai) {
#pragma unroll
            for (int m = 0; m < 4; ++m) {
                const int row = u.pm * 256 + ai * 128 + wr * 64 + m * 16 + fr; const float rs = rsv8[ai][m];
#pragma unroll
                for (int bj = 0; bj < 2; ++bj) { const size_t off = (size_t)row * 1024 + cc + 128 * bj;
                    f32x4 v0 = acc[ai][bj][m][0] * rs + bv[bj][0], v1 = acc[ai][bj][m][1] * rs + bv[bj][1];
                    if (type == 1) {
#pragma unroll
                        for (int i = 0; i < 4; ++i) { const float f0 = fmaxf(lb[bj][0][i] + (1.0f - lb[bj][0][i]) * sigmoid_f(v0[i]), 1e-30f), f1 = fmaxf(lb[bj][1][i] + (1.0f - lb[bj][1][i]) * sigmoid_f(v1[i]), 1e-30f);
                            v0[i] = __logf(f0); v1[i] = __logf(f1); }
                        *(f32x4*)(LOGF + off) = v0; *(f32x4*)(LOGF + off + 4) = v1;
                    } else {
                        if (type != 2) {
#pragma unroll
                            for (int i = 0; i < 4; ++i) { v0[i] = silu_f(v0[i]); v1[i] = silu_f(v1[i]); } }
                        bf16_t* dst = QVG + (size_t)(type == 0 ? 0 : (type == 2 ? 1 : 2)) * 33554432u;
                        *(u32x4*)(dst + off) = pack8(v0, v1);
                    } }
            } }
    }
};

struct EpiAttnIn {
    static constexpr bool PERM = true, AFTER_DRAIN = false;
    bf16_t* QKV; const float* ssq; const float* bias; const float* qkg; const float* rope;
    __device__ __forceinline__ void operator()(const f32x4 (&acc)[2][2][4][2], const Unit& u, int wr, int wc, int fr, int fq) const {
        const int b = u.pm >> 5, bcol = u.pn * 256 + wc * 32 + 8 * fq;
        f32x4 bv[2][2];
#pragma unroll
        for (int bj = 0; bj < 2; ++bj)
#pragma unroll
            for (int n = 0; n < 2; ++n) bv[bj][n] = *(const f32x4*)(bias + b * BIAS_LD + bcol + 128 * bj + 4 * n);
        if (u.pn >= 8) {
#pragma unroll
            for (int ai = 0; ai < 2; ++ai) { float rsv[4]; row_rstd4(ssq, u.pm * 256 + ai * 128 + wr * 64 + fr, fq, rsv);
#pragma unroll
                for (int m = 0; m < 4; ++m) { const int row = u.pm * 256 + ai * 128 + wr * 64 + m * 16 + fr; const float rs = rsv[m];
#pragma unroll
                    for (int bj = 0; bj < 2; ++bj) *(u32x4*)(QKV + (size_t)67108864u + (size_t)row * 1024 + (u.pn - 8) * 256 + 128 * bj + wc * 32 + 8 * fq) = pack8(acc[ai][bj][m][0] * rs + bv[bj][0], acc[ai][bj][m][1] * rs + bv[bj][1]); } }
        } else {
            const int which = u.pn >> 2, gidx = (u.pn & 3) * 4 + wc; bf16_t* dst = QKV + (size_t)which * 33554432u; const float osc = which ? 1.0f : 0.125f * LOG2E;
            f32x4 gv[2][2];
#pragma unroll
            for (int bj = 0; bj < 2; ++bj)
#pragma unroll
                for (int n = 0; n < 2; ++n) gv[bj][n] = *(const f32x4*)(qkg + which * 64 + 32 * bj + 8 * fq + 4 * n);
#pragma unroll
            for (int ai = 0; ai < 2; ++ai) { float rsv[4]; row_rstd4(ssq, u.pm * 256 + ai * 128 + wr * 64 + fr, fq, rsv);
#pragma unroll
                for (int m = 0; m < 4; ++m) { const int row = u.pm * 256 + ai * 128 + wr * 64 + m * 16 + fr; const float rs = rsv[m];
                    f32x4 y[2][2]; float ss = 0.f;
#pragma unroll
                    for (int bj = 0; bj < 2; ++bj)
#pragma unroll
                        for (int n = 0; n < 2; ++n) { y[bj][n] = acc[ai][bj][m][n] * rs + bv[bj][n]; const f32x4 t = y[bj][n]; ss += (t[0] * t[0] + t[1] * t[1]) + (t[2] * t[2] + t[3] * t[3]); }
                    ss += __shfl_xor(ss, 16); ss += __shfl_xor(ss, 32);
                    const float r = __builtin_amdgcn_rsqf(ss * (1.0f / 64.0f) + RMS_EPS);
#pragma unroll
                    for (int bj = 0; bj < 2; ++bj)
#pragma unroll
                        for (int n = 0; n < 2; ++n) y[bj][n] = y[bj][n] * r * gv[bj][n];
                    const float* rp = rope + (size_t)row * 16;
#pragma unroll
                    for (int n = 0; n < 2; ++n) { const f32x4 cn = *(const f32x4*)(rp + 4 * n), sn = *(const f32x4*)(rp + 8 + 4 * n); f32x4 pn;
#pragma unroll
                        for (int i = 0; i < 4; ++i) pn[i] = __shfl_xor(y[0][n][i], 16);
                        if (fq == 0) y[0][n] = y[0][n] * cn - pn * sn; else if (fq == 1) y[0][n] = y[0][n] * cn + pn * sn; }
#pragma unroll
                    for (int bj = 0; bj < 2; ++bj) *(u32x4*)(dst + (size_t)row * 1024 + gidx * 64 + 32 * bj + 8 * fq) = pack8(y[bj][0] * osc, y[bj][1] * osc);
                } }
        }
    }
};

struct EpiConvIn {
    static constexpr bool PERM = true, AFTER_DRAIN = false;
    bf16_t* BG; bf16_t* U2; const float* ssq; const float* bias;
    __device__ __forceinline__ void operator()(const f32x4 (&acc)[2][2][4][2], const Unit& u, int wr, int wc, int fr, int fq) const {
        float rsv8[2][4]; row_rstd8(ssq, u.pm * 256 + wr * 64 + fr, fq, rsv8);
        const int b = u.pm >> 5, bcol = u.pn * 256 + wc * 32 + 8 * fq;
        f32x4 bv[2][2];
#pragma unroll
        for (int bj = 0; bj < 2; ++bj)
#pragma unroll
            for (int n = 0; n < 2; ++n) bv[bj][n] = *(const f32x4*)(bias + b * BIAS_LD + bcol + 128 * bj + 4 * n);
        if (u.pn < 8) {
#pragma unroll
            for (int ai = 0; ai < 2; ++ai) {
#pragma unroll
                for (int m = 0; m < 4; ++m) { const int row = u.pm * 256 + ai * 128 + wr * 64 + m * 16 + fr; const float rs = rsv8[ai][m];
                    const f32x4 c0 = acc[ai][0][m][0] * rs + bv[0][0], c1 = acc[ai][0][m][1] * rs + bv[0][1], u0 = acc[ai][1][m][0] * rs + bv[1][0], u1 = acc[ai][1][m][1] * rs + bv[1][1];
                    *(u32x4*)(U2 + (size_t)row * 1024 + u.pn * 128 + wc * 32 + 8 * fq) =
#if defined(CONV_CG)
                        pack8(c0, c1);
#elif defined(CONV_U)
                        pack8(u0, u1);
#else
                        pack8(c0 * u0, c1 * u1);
#endif
                } }
        } else {
#pragma unroll
            for (int ai = 0; ai < 2; ++ai) {
#pragma unroll
                for (int m = 0; m < 4; ++m) { const int row = u.pm * 256 + ai * 128 + wr * 64 + m * 16 + fr; const float rs = rsv8[ai][m];
#pragma unroll
                    for (int bj = 0; bj < 2; ++bj) *(u32x4*)(BG + (size_t)row * 1024 + (u.pn - 8) * 256 + 128 * bj + wc * 32 + 8 * fq) = pack8(acc[ai][bj][m][0] * rs + bv[bj][0], acc[ai][bj][m][1] * rs + bv[bj][1]); } }
        }
    }
};

template <class Epi, class Sched, bool ALIGN_EPI = false, bool SP2 = false>
__device__ __forceinline__ void gemm_phase(PG8_LAS unsigned char* lds, const Gemm g, const Sched& S, const Epi& E) {
    const int tid = opaque_tid(), wid = __builtin_amdgcn_readfirstlane(tid >> 6), lane = tid & 63, wr = wid >> 2, wc = wid & 3, fr = lane & 15, fq = lane >> 4;
    const int K = g.K, nt = K / BK;
    unsigned voffA[2], voffB[2];
#pragma unroll
    for (int i = 0; i < 2; ++i) { int R, C; stage_rc(tid * 16 + i * 8192, R, C); const int Rb = Epi::PERM ? ((R & ~31) + perm32(R & 31)) : R;
        voffA[i] = (unsigned)(R * K + C) * 2u; voffB[i] = (unsigned)(Rb * K + C) * 2u; }
    const size_t kstep = (size_t)(BK * 2);
    const size_t hstep = (size_t)HALF * K * 2;
    const size_t tstep = 2 * hstep;
    const unsigned ldsw = (unsigned)wid * 1024u;
    const int aoff = lds_byte(wr * 64 + fr, fq * 8), boff = lds_byte(wc * 32 + fr, fq * 8);
#define PG8_SA(b, h) (((b) * 2 + (h)) * HTB)
#define PG8_SB(b, h) ((4 + (b) * 2 + (h)) * HTB)
#define PG8_STAGE(bufoff, gbase, voff) do { _Pragma("unroll") for (int _i = 0; _i < 2; ++_i) \
        __builtin_amdgcn_global_load_lds((const unsigned*)((const char*)(gbase) + (voff)[_i]), (PG8_LAS unsigned*)(lds + (bufoff) + ldsw + _i * 8192), 16, 0, 0); } while (0)
#define PG8_LDA(dst, b, h) do { _Pragma("unroll") for (int m = 0; m < 4; ++m) _Pragma("unroll") for (int k = 0; k < 2; ++k) dst[m][k] = *(const PG8_LAS bf16x8*)(lds + PG8_SA(b, h) + aoff + m * 2048 + k * 1024); } while (0)
#define PG8_LDB(dst, b, h) do { _Pragma("unroll") for (int n = 0; n < 2; ++n) _Pragma("unroll") for (int k = 0; k < 2; ++k) dst[n][k] = *(const PG8_LAS bf16x8*)(lds + PG8_SB(b, h) + boff + n * 2048 + k * 1024); } while (0)
#define PG8_MMA(ai, bj, At, Bt) do { __builtin_amdgcn_s_setprio(1); _Pragma("unroll") for (int m = 0; m < 4; ++m) _Pragma("unroll") for (int n = 0; n < 2; ++n) _Pragma("unroll") for (int k = 0; k < 2; ++k) \
        acc[ai][bj][m][n] = __builtin_amdgcn_mfma_f32_16x16x32_bf16(Bt[n][k], At[m][k], acc[ai][bj][m][n], 0, 0, 0); __builtin_amdgcn_s_setprio(0); } while (0)
#define PG8_WAIT_V(n) asm volatile("s_waitcnt vmcnt(" #n ")" ::: "memory")
#define PG8_WAIT_L(n) asm volatile("s_waitcnt lgkmcnt(" #n ")" ::: "memory")
#define PG8_BAR __builtin_amdgcn_s_barrier()
#define PG8_SCHED __builtin_amdgcn_sched_barrier(0)
    Unit cur, nxt; int ui = 0;
    if (!S.next(0, cur)) return;
    f32x4 acc[2][2][4][2];
#pragma unroll
    for (int a = 0; a < 2; ++a)
#pragma unroll
        for (int b = 0; b < 2; ++b)
#pragma unroll
            for (int m = 0; m < 4; ++m)
#pragma unroll
                for (int n = 0; n < 2; ++n) acc[a][b][m][n] = (f32x4){0.f, 0.f, 0.f, 0.f};
    bf16x8 At[4][2], B0[2][2], B1[2][2];
    const char* cA = (const char*)g.A + (size_t)cur.pm * tstep; const char* cB = (const char*)g.Bt + (size_t)cur.pn * tstep;
    S.a_ready(cur);
    if constexpr (SP2) {
        PG8_STAGE(PG8_SB(0, 0), cB, voffB); PG8_STAGE(PG8_SB(0, 1), cB + hstep, voffB); PG8_STAGE(PG8_SA(0, 0), cA, voffA); PG8_STAGE(PG8_SA(0, 1), cA + hstep, voffA);
        if (wr == 1) PG8_BAR;
        PG8_WAIT_V(2); PG8_BAR;
        PG8_STAGE(PG8_SB(1, 0), cB + kstep, voffB); PG8_STAGE(PG8_SA(1, 0), cA + kstep, voffA); PG8_STAGE(PG8_SB(1, 1), cB + hstep + kstep, voffB);
        PG8_WAIT_V(6); PG8_BAR;
    } else {
        PG8_STAGE(PG8_SB(0, 0), cB, voffB); PG8_STAGE(PG8_SA(0, 0), cA, voffA); PG8_STAGE(PG8_SB(0, 1), cB + hstep, voffB); PG8_STAGE(PG8_SA(0, 1), cA + hstep, voffA);
        if (wr == 1) PG8_BAR;
        PG8_WAIT_V(4); PG8_BAR;
        PG8_STAGE(PG8_SB(1, 0), cB + kstep, voffB); PG8_STAGE(PG8_SA(1, 0), cA + kstep, voffA); PG8_STAGE(PG8_SB(1, 1), cB + hstep + kstep, voffB);
        PG8_WAIT_V(6); PG8_BAR;
    }
    for (;;) {
        const bool has_next = S.next(ui + 1, nxt);
        const char* nA = has_next ? (const char*)g.A + (size_t)nxt.pm * tstep : cA; const char* nB = has_next ? (const char*)g.Bt + (size_t)nxt.pn * tstep : cB;
        for (int t = 0; t < nt; t += 2) {
            const bool last = (t == nt - 2);
            const char* a1 = cA + (size_t)(t + 1) * kstep;
            const char* a2 = last ? nA : cA + (size_t)(t + 2) * kstep; const char* b2 = last ? nB : cB + (size_t)(t + 2) * kstep;
            const char* a3 = a2 + kstep; const char* b3 = b2 + kstep;
            if (last && has_next) S.a_ready(nxt);
            if constexpr (SP2) {
            PG8_LDB(B0, 0, 0); PG8_LDB(B1, 0, 1); PG8_SCHED; PG8_LDA(At, 0, 0); PG8_STAGE(PG8_SA(1, 1), a1 + hstep, voffA);
            PG8_WAIT_V(8); PG8_WAIT_L(0); PG8_BAR; PG8_MMA(0, 0, At, B0); PG8_MMA(0, 1, At, B1); PG8_BAR; PG8_SCHED;
            PG8_LDA(At, 0, 1); PG8_STAGE(PG8_SB(0, 0), b2, voffB); PG8_STAGE(PG8_SB(0, 1), b2 + hstep, voffB); PG8_STAGE(PG8_SA(0, 0), a2, voffA);
            PG8_WAIT_V(8); PG8_WAIT_L(0); PG8_BAR; PG8_MMA(1, 0, At, B0); PG8_MMA(1, 1, At, B1); PG8_BAR; PG8_SCHED;
            PG8_LDB(B0, 1, 0); PG8_LDB(B1, 1, 1); PG8_SCHED; PG8_LDA(At, 1, 0); PG8_STAGE(PG8_SA(0, 1), a2 + hstep, voffA);
            PG8_WAIT_V(8); PG8_WAIT_L(0); PG8_BAR; PG8_MMA(0, 0, At, B0); PG8_MMA(0, 1, At, B1); PG8_BAR; PG8_SCHED;
            PG8_LDA(At, 1, 1); PG8_STAGE(PG8_SB(1, 0), b3, voffB); PG8_STAGE(PG8_SB(1, 1), b3 + hstep, voffB); PG8_STAGE(PG8_SA(1, 0), a3, voffA);
            PG8_WAIT_V(8); PG8_WAIT_L(0); PG8_BAR; PG8_MMA(1, 0, At, B0); PG8_MMA(1, 1, At, B1); PG8_BAR; PG8_SCHED;
            } else {
            PG8_LDB(B0, 0, 0); PG8_SCHED; PG8_LDA(At, 0, 0); PG8_STAGE(PG8_SA(1, 1), a1 + hstep, voffA);
            PG8_WAIT_L(8); PG8_BAR; PG8_WAIT_L(0); PG8_MMA(0, 0, At, B0); PG8_BAR; PG8_SCHED;
            PG8_LDB(B1, 0, 1); PG8_STAGE(PG8_SB(0, 0), b2, voffB);
            PG8_BAR; PG8_WAIT_L(0); PG8_MMA(0, 1, At, B1); PG8_BAR;
            PG8_LDA(At, 0, 1); PG8_STAGE(PG8_SA(0, 0), a2, voffA);
            PG8_BAR; PG8_WAIT_L(0); PG8_MMA(1, 0, At, B0); PG8_BAR; PG8_SCHED;
            PG8_STAGE(PG8_SB(0, 1), b2 + hstep, voffB);
            PG8_WAIT_V(6); PG8_BAR; PG8_MMA(1, 1, At, B1); PG8_BAR;
            PG8_LDB(B0, 1, 0); PG8_SCHED; PG8_LDA(At, 1, 0); PG8_STAGE(PG8_SA(0, 1), a2 + hstep, voffA);
            PG8_WAIT_L(8); PG8_BAR; PG8_WAIT_L(0); PG8_MMA(0, 0, At, B0); PG8_BAR; PG8_SCHED;
            PG8_LDB(B1, 1, 1); PG8_STAGE(PG8_SB(1, 0), b3, voffB);
            PG8_BAR; PG8_WAIT_L(0); PG8_MMA(0, 1, At, B1); PG8_BAR;
            PG8_LDA(At, 1, 1); PG8_STAGE(PG8_SA(1, 0), a3, voffA);
            PG8_BAR; PG8_WAIT_L(0); PG8_MMA(1, 0, At, B0); PG8_BAR; PG8_SCHED;
            PG8_STAGE(PG8_SB(1, 1), b3 + hstep, voffB);
            PG8_WAIT_V(6); PG8_BAR; PG8_MMA(1, 1, At, B1); PG8_BAR;
            }
        }
        if constexpr (ALIGN_EPI) { if (wr == 0) PG8_BAR; }
        if constexpr (!Epi::AFTER_DRAIN) { E(acc, cur, wr, wc, fr, fq); S.done(cur); }
        if (!has_next) break;
#pragma unroll
        for (int a = 0; a < 2; ++a)
#pragma unroll
            for (int b = 0; b < 2; ++b)
#pragma unroll
                for (int m = 0; m < 4; ++m)
#pragma unroll
                    for (int n = 0; n < 2; ++n) acc[a][b][m][n] = (f32x4){0.f, 0.f, 0.f, 0.f};
        cur = nxt; cA = nA; cB = nB; ++ui;
        if constexpr (ALIGN_EPI) { if (wr == 1) PG8_BAR; }
    }
    PG8_WAIT_V(0);
    if constexpr (!ALIGN_EPI) { if (wr == 0) PG8_BAR; }
    PG8_BAR;
    if constexpr (Epi::AFTER_DRAIN) { E.fused(acc, cur, wr, wc, fr, fq, lds, wid, lane); S.done(cur); }
#undef PG8_SA
#undef PG8_SB
#undef PG8_STAGE
#undef PG8_LDA
#undef PG8_LDB
#undef PG8_MMA
#undef PG8_WAIT_V
#undef PG8_WAIT_L
#undef PG8_BAR
#undef PG8_SCHED
}
}
#include <hip/hip_bf16.h>
#include <cmath>
namespace attn_body {
using bf16=__hip_bfloat16;
using bf16x8=__attribute__((ext_vector_type(8)))short;
using s16x4=__attribute__((ext_vector_type(4)))short;
using f32x16=__attribute__((ext_vector_type(16)))float;
using u32x4=__attribute__((ext_vector_type(4)))unsigned;
constexpr int BATCH=4,NHEAD=16,SEQ=8192,D=64,DM=NHEAD*D;
constexpr int NW=8,QBLK=32,QB=QBLK*NW,KVBLK=64,NQB=SEQ/QB;
constexpr int ATTN_PITCH=DM, ATTN_UNIT_ROWS=QB;
__device__ __forceinline__ int crow(int r,int hi){return (r&3)+8*(r>>2)+4*hi;}
#define SBAR() __builtin_amdgcn_sched_barrier(0)
__device__ __forceinline__ void cmask(f32x16&p0,f32x16&p1,int jb,int qrel,int hi){
  const float NEG=-INFINITY; int kb=64*jb+4*hi;
  #pragma unroll
  for(int r=0;r<16;++r){int kv=kb+(r&3)+8*(r>>2); if(kv>qrel)p0[r]=NEG; if(kv+32>qrel)p1[r]=NEG;}
}

constexpr int NSLOT=3, SLOTB=8192;
constexpr int LDS_K=0, LDS_V=NSLOT*SLOTB, LDS_WS=2*NSLOT*SLOTB, LDS_OST=LDS_WS+NW*64*4, LDS_BYTES=LDS_OST+NW*4096;
constexpr float C2=0.125f*1.4426950408889634f;
__device__ __forceinline__ void glds16(const void*gsrc,unsigned lds_dst){unsigned keep;
  asm volatile("s_mov_b32 %0, m0\n\ts_mov_b32 m0, %2\n\ts_nop 0\n\tglobal_load_lds_dwordx4 %1, off\n\ts_mov_b32 m0, %0":"=&s"(keep):"v"(gsrc),"s"(lds_dst):"memory");}
__device__ __forceinline__ float max3f(float a,float b,float c){float r;asm("v_max3_f32 %0, %1, %2, %3":"=v"(r):"v"(a),"v"(b),"v"(c));return r;}
__device__ __forceinline__ float max2f(float a,float b){float r;asm("v_max_f32_e32 %0, %1, %2":"=v"(r):"v"(a),"v"(b));return r;}
__device__ __forceinline__ float fadd_s(float a,float b){float r;asm("v_add_f32_e32 %0, %1, %2":"=v"(r):"v"(a),"v"(b));return r;}
__device__ __forceinline__ float fsub_s(float a,float b){float r;asm("v_sub_f32_e32 %0, %1, %2":"=v"(r):"v"(a),"v"(b));return r;}
typedef float f32x2_t __attribute__((ext_vector_type(2))); typedef __bf16 bf16x2_t __attribute__((ext_vector_type(2)));
__device__ __forceinline__ unsigned cvtpk_s(float lo,float hi){f32x2_t v={lo,hi};bf16x2_t b=__builtin_convertvector(v,bf16x2_t);return __builtin_bit_cast(unsigned,b);}
#define WAIT_BAR(N) asm volatile("s_waitcnt vmcnt(" #N ") lgkmcnt(0)\n\ts_barrier":::"memory")

__device__ __forceinline__ void qkt(f32x16&p0,f32x16&p1,const char*Kslot,const bf16x8*qr,const f32x16&negm,int r32,int hi){
  const char*kb=Kslot+hi*1024+r32*16;
  #pragma unroll
  for(int d0=0;d0<4;++d0){
    const bf16x8 b0=*reinterpret_cast<const bf16x8*>(kb+d0*2048);
    const bf16x8 b1=*reinterpret_cast<const bf16x8*>(kb+d0*2048+512);
    if(d0==0){p0=__builtin_amdgcn_mfma_f32_32x32x16_bf16(b0,qr[0],negm,0,0,0);p1=__builtin_amdgcn_mfma_f32_32x32x16_bf16(b1,qr[0],negm,0,0,0);}
    else{p0=__builtin_amdgcn_mfma_f32_32x32x16_bf16(b0,qr[d0],p0,0,0,0);p1=__builtin_amdgcn_mfma_f32_32x32x16_bf16(b1,qr[d0],p1,0,0,0);}}
}
typedef __attribute__((address_space(3))) const char* lds_cptr;
typedef short v4i16_t __attribute__((ext_vector_type(4)));
__device__ __forceinline__ void kload8(bf16x8*kf,lds_cptr kp){
  kf[0]=*(const __attribute__((address_space(3))) bf16x8*)(kp);      kf[1]=*(const __attribute__((address_space(3))) bf16x8*)(kp+512);
  kf[2]=*(const __attribute__((address_space(3))) bf16x8*)(kp+2048); kf[3]=*(const __attribute__((address_space(3))) bf16x8*)(kp+2560);
  kf[4]=*(const __attribute__((address_space(3))) bf16x8*)(kp+4096); kf[5]=*(const __attribute__((address_space(3))) bf16x8*)(kp+4608);
  kf[6]=*(const __attribute__((address_space(3))) bf16x8*)(kp+6144); kf[7]=*(const __attribute__((address_space(3))) bf16x8*)(kp+6656);
}
__device__ __forceinline__ void kload2(bf16x8*kf,lds_cptr kp,int j){ kf[2*j]=*(const __attribute__((address_space(3))) bf16x8*)(kp+j*2048); kf[2*j+1]=*(const __attribute__((address_space(3))) bf16x8*)(kp+j*2048+512); }
__device__ __forceinline__ s16x4 vtr(lds_cptr p){ return __builtin_bit_cast(s16x4,__builtin_amdgcn_ds_read_tr16_b64_v4i16((__attribute__((address_space(3))) v4i16_t*)p)); }
__device__ __forceinline__ float rowmax(const f32x16&p0,const f32x16&p1){
  float a=max3f(p0[0],p0[1],p1[0]),b=max3f(p0[2],p0[3],p1[1]);a=max3f(a,p1[2],p1[3]);
  #pragma unroll
  for(int r=4;r<16;r+=4){a=max3f(a,p0[r],p0[r+1]);b=max3f(b,p0[r+2],p0[r+3]);a=max3f(a,p1[r],p1[r+1]);b=max3f(b,p1[r+2],p1[r+3]);}
  const float m=max2f(a,b);
  auto rr=__builtin_amdgcn_permlane32_swap(__float_as_uint(m),__float_as_uint(m),false,false);
  return max2f(__uint_as_float(rr[0]),__uint_as_float(rr[1]));
}
__device__ __forceinline__ void pv(f32x16*o,int vb,bf16x8 pa0,bf16x8 pa1,bf16x8 pa2,bf16x8 pa3){
  #pragma unroll
  for(int d0=0;d0<2;++d0){s16x4 lo[4],hi[4];
    #pragma unroll
    for(int ks=0;ks<4;++ks){
      asm volatile("ds_read_b64_tr_b16 %0,%1 offset:%c2":"=&v"(lo[ks]):"v"(vb),"i"(d0*4096+ks*1024):"memory");
      asm volatile("ds_read_b64_tr_b16 %0,%1 offset:%c2":"=&v"(hi[ks]):"v"(vb),"i"(d0*4096+ks*1024+512):"memory");}
    asm volatile("s_waitcnt lgkmcnt(0)":::"memory");SBAR();
    #define PK(k) (bf16x8){lo[k][0],lo[k][1],lo[k][2],lo[k][3],hi[k][0],hi[k][1],hi[k][2],hi[k][3]}
    o[d0]=__builtin_amdgcn_mfma_f32_32x32x16_bf16(pa0,PK(0),o[d0],0,0,0);
    o[d0]=__builtin_amdgcn_mfma_f32_32x32x16_bf16(pa1,PK(1),o[d0],0,0,0);
    o[d0]=__builtin_amdgcn_mfma_f32_32x32x16_bf16(pa2,PK(2),o[d0],0,0,0);
    o[d0]=__builtin_amdgcn_mfma_f32_32x32x16_bf16(pa3,PK(3),o[d0],0,0,0);
    #undef PK
  }
}

#ifndef ATTN_STORE16
#define ATTN_STORE16(p,v) (*(u32x4*)(p)=(v))
#endif
template<int THRL,bool DOMAX> __device__ __forceinline__ void attn_unit(int b,int qc,int vc,int qb,const bf16*Q,const bf16*__restrict__ K,const bf16*__restrict__ V,bf16*O,char*shm){
  const int tid=opaque_tid(),lane=tid&63,r32=lane&31,hi=lane>>5; const int wid=__builtin_amdgcn_readfirstlane(tid>>6);
  const long rowbase=(long)b*SEQ; const int q0=qb*QB;
  const bf16*Qw=Q+(rowbase+q0+wid*QBLK)*DM+qc;
  const bf16*Kh=K+rowbase*DM+qc,*Vh=V+rowbase*DM+vc;
  const unsigned lds0=(unsigned)(uintptr_t)shm;
  float*wsf=(float*)(shm+LDS_WS)+wid*64;
  const bf16*ksrc=Kh+(long)lane*DM+wid*8;
  const bf16*vsrc=Vh+(long)(16*(wid&3)+(lane>>2))*DM+(wid>>2)*32+(lane&3)*8;
  const unsigned kdst=lds0+LDS_K+wid*1024, vdst=lds0+LDS_V+wid*1024;
  #define DMA_K(t,slot) glds16(ksrc+(long)(t)*KVBLK*DM,(unsigned)__builtin_amdgcn_readfirstlane(kdst+(slot)))
  #define DMA_V(t,slot) glds16(vsrc+(long)(t)*KVBLK*DM,(unsigned)__builtin_amdgcn_readfirstlane(vdst+(slot)))
  const int vb0=(int)(lds0+LDS_V)+((lane>>4)&1)*32+(lane&3)*8+(4*hi+((lane&15)>>2))*64;
  const char*Kbase=shm+LDS_K; bf16x8 kf[8];
  const lds_cptr shm3=(lds_cptr)shm; const lds_cptr kp0=shm3+LDS_K+hi*1024+r32*16; const lds_cptr vp0=shm3+LDS_V+((lane>>4)&1)*32+(lane&3)*8+(4*hi+((lane&15)>>2))*64;
  const int NT=(q0+QB)/KVBLK;
  DMA_K(0,0);DMA_V(0,0);DMA_K(1,SLOTB);
  bf16x8 qr[4];
  #pragma unroll
  for(int d0=0;d0<4;++d0)qr[d0]=*reinterpret_cast<const bf16x8*>(&Qw[(long)r32*DM+d0*16+hi*8]);
  float mhat=0.f,l_reg=0.f;f32x16 o[2];o[0]=f32x16{};o[1]=f32x16{};f32x16 negm=f32x16{};asm volatile("":"+v"(negm));
  const int qrel=wid*QBLK+r32;
  #define CMASK(P0,P1,t) do{int jb_=(t)-(NT-4); if(jb_>=0)cmask(P0,P1,jb_,qrel,hi);}while(0)
  bool resc=false;
  #define START(P0,P1) do{ const float rm=rowmax(P0,P1); resc=false; \
    { const float dl=rm; mhat=fadd_s(mhat,dl); \
      _Pragma("unroll") for(int r=0;r<16;++r){P0[r]=fsub_s(P0[r],dl);P1[r]=fsub_s(P1[r],dl);} \
      _Pragma("unroll") for(int r=0;r<16;++r)negm[r]=-mhat; asm volatile("":"+v"(negm)); } \
    _Pragma("unroll") for(int r=0;r<16;++r)P0[r]=__builtin_amdgcn_exp2f(P0[r]); }while(0)
  #define RESC() do{ if(resc){ asm volatile("s_waitcnt lgkmcnt(0)":::"memory"); \
      _Pragma("unroll") for(int d_=0;d_<2;++d_) _Pragma("unroll") for(int r=0;r<16;++r)o[d_][r]*=wsf[crow(r,hi)]; } }while(0)
  f32x16 pA0,pA1,pB0,pB1;
  int sl_prev=0,sl_cur=0,sl_next=SLOTB;
  #define ROT() do{sl_prev=sl_cur;sl_cur=sl_next;sl_next=(sl_next==(NSLOT-1)*SLOTB)?0:sl_next+SLOTB;}while(0)
  DMA_K(2,2*SLOTB);
  WAIT_BAR(3);
  qkt(pA0,pA1,Kbase,qr,negm,r32,hi);asm volatile("s_nop 15\n\ts_nop 7":"+v"(pA0),"+v"(pA1));CMASK(pA0,pA1,0);
  START(pA0,pA1);
  _Pragma("unroll") for(int r=0;r<16;++r)pA1[r]=__builtin_amdgcn_exp2f(pA1[r]);
  WAIT_BAR(0);
  DMA_K(3,0);DMA_V(1,SLOTB);
  ROT();
  kload8(kf,kp0+sl_cur);
  WAIT_BAR(2);
  s16x4 vlo[8],vhi[8]; u32x4 pw0,pw1,pw2,pw3;
  #define PKW(P,B) cvtpk_s(P[B],P[B+1])
  #define PAF(k) __builtin_bit_cast(bf16x8,pw##k)
  #define VFR(i) (bf16x8){vlo[i][0],vlo[i][1],vlo[i][2],vlo[i][3],vhi[i][0],vhi[i][1],vhi[i][2],vhi[i][3]}
  #define PIN(x) asm volatile("":"+v"(x))
  #define MX3(a,b,c) __builtin_fmaxf(__builtin_fmaxf((a),(b)),(c))
  #define GAPA(MF,A0,A1,A2,A3,W0,W1,PW) do{ MF; sacc+=A0; sacc+=A1; sacc+=A2; sacc+=A3; PIN(sacc); W0; W1; PIN(PW); SBAR(); }while(0)
  #define EX(v) __builtin_amdgcn_exp2f(v)
  #define GAPB(MF,X,B) do{ MF; X[B]=EX(X[B]); X[B+1]=EX(X[B+1]); X[B+2]=EX(X[B+2]); X[B+3]=EX(X[B+3]); PIN(X); SBAR(); }while(0)
  #define VRD(i) do{ vlo[i]=vtr(vp_+(((i)>>2)*4096+((i)&3)*1024)); vhi[i]=vtr(vp_+(((i)>>2)*4096+((i)&3)*1024+512)); }while(0)
  #define KRD(G,j) do{ if(G){ kload2(kf,kp0+sl_next,j); SBAR(); } }while(0)
  #define STEP(C0,C1,P0,P1,t,GK,GV,GL) do{ SBAR(); \
    const lds_cptr vp_=vp0+sl_prev; \
    VRD(0); SBAR(); float sacc=(P0[0]+P0[1]); \
    GAPA(C0=__builtin_amdgcn_mfma_f32_32x32x16_bf16(kf[0],qr[0],negm,0,0,0), P0[2],P0[3],P0[4],P0[5],     pw0[0]=PKW(P0,0), pw0[1]=PKW(P0,2), pw0); \
    VRD(4); SBAR(); GAPA(C1=__builtin_amdgcn_mfma_f32_32x32x16_bf16(kf[1],qr[0],negm,0,0,0), P0[6],P0[7],P0[8],P0[9],     pw0[2]=PKW(P0,4), pw0[3]=PKW(P0,6), pw0); \
    VRD(1); SBAR(); GAPA(C0=__builtin_amdgcn_mfma_f32_32x32x16_bf16(kf[2],qr[1],C0,0,0,0),   P0[10],P0[11],P0[12],P0[13], pw1[0]=PKW(P0,8), pw1[1]=PKW(P0,10), pw1); \
    VRD(5); SBAR(); GAPA(C1=__builtin_amdgcn_mfma_f32_32x32x16_bf16(kf[3],qr[1],C1,0,0,0),   P0[14],P0[15],P1[0],P1[1],   pw1[2]=PKW(P0,12),pw1[3]=PKW(P0,14), pw1); \
    VRD(2); SBAR(); GAPA(C0=__builtin_amdgcn_mfma_f32_32x32x16_bf16(kf[4],qr[2],C0,0,0,0),   P1[2],P1[3],P1[4],P1[5],     pw2[0]=PKW(P1,0), pw2[1]=PKW(P1,2), pw2); \
    VRD(6); SBAR(); GAPA(C1=__builtin_amdgcn_mfma_f32_32x32x16_bf16(kf[5],qr[2],C1,0,0,0),   P1[6],P1[7],P1[8],P1[9],     pw2[2]=PKW(P1,4), pw2[3]=PKW(P1,6), pw2); \
    VRD(3); SBAR(); GAPA(C0=__builtin_amdgcn_mfma_f32_32x32x16_bf16(kf[6],qr[3],C0,0,0,0),   P1[10],P1[11],P1[12],P1[13], pw3[0]=PKW(P1,8), pw3[1]=PKW(P1,10), pw3); \
    VRD(7); SBAR(); GAPA(C1=__builtin_amdgcn_mfma_f32_32x32x16_bf16(kf[7],qr[3],C1,0,0,0),   P1[14],P1[15],0.f,0.f,       pw3[2]=PKW(P1,12),pw3[3]=PKW(P1,14), pw3); \
    l_reg+=sacc; \
    if(GK){DMA_K((t)+3,sl_cur);} if(GV){DMA_V((t)+1,sl_next);} \
    CMASK(C0,C1,t); \
    if(DOMAX) { float a=MX3(C0[0],C0[1],C1[0]),b=MX3(C0[2],C0[3],C1[1]); a=MX3(a,C1[2],C1[3]); \
      _Pragma("unroll") for(int r=4;r<16;r+=4){a=MX3(a,C0[r],C0[r+1]);b=MX3(b,C0[r+2],C0[r+3]);a=MX3(a,C1[r],C1[r+1]);b=MX3(b,C1[r+2],C1[r+3]);} \
      float rm=__builtin_fmaxf(a,b); { auto rr=__builtin_amdgcn_permlane32_swap(__float_as_uint(rm),__float_as_uint(rm),false,false); rm=__builtin_fmaxf(__uint_as_float(rr[0]),__uint_as_float(rr[1])); } \
      resc=false; \
      if(__builtin_expect(__any(rm>(float)THRL),0)){ const float dl=__builtin_fmaxf(rm,0.f); mhat+=dl; \
        _Pragma("unroll") for(int r=0;r<16;++r){C0[r]-=dl;C1[r]-=dl;} \
        _Pragma("unroll") for(int r=0;r<16;++r)negm[r]=-mhat; asm volatile("":"+v"(negm)); \
        const float f=__builtin_amdgcn_exp2f(-dl); l_reg*=f; if(hi==0)wsf[r32]=f; resc=true; } } \
    SBAR(); \
    GAPB(o[0]=__builtin_amdgcn_mfma_f32_32x32x16_bf16(PAF(0),VFR(0),o[0],0,0,0), C0,0); \
    GAPB(o[1]=__builtin_amdgcn_mfma_f32_32x32x16_bf16(PAF(0),VFR(4),o[1],0,0,0), C0,4); \
    KRD(GL,0); GAPB(o[0]=__builtin_amdgcn_mfma_f32_32x32x16_bf16(PAF(1),VFR(1),o[0],0,0,0), C0,8); \
    KRD(GL,1); GAPB(o[1]=__builtin_amdgcn_mfma_f32_32x32x16_bf16(PAF(1),VFR(5),o[1],0,0,0), C0,12); \
    KRD(GL,2); GAPB(o[0]=__builtin_amdgcn_mfma_f32_32x32x16_bf16(PAF(2),VFR(2),o[0],0,0,0), C1,0); \
    KRD(GL,3); GAPB(o[1]=__builtin_amdgcn_mfma_f32_32x32x16_bf16(PAF(2),VFR(6),o[1],0,0,0), C1,4); \
    GAPB(o[0]=__builtin_amdgcn_mfma_f32_32x32x16_bf16(PAF(3),VFR(3),o[0],0,0,0), C1,8); \
    GAPB(o[1]=__builtin_amdgcn_mfma_f32_32x32x16_bf16(PAF(3),VFR(7),o[1],0,0,0), C1,12); \
    }while(0)
  int t=1;
  #undef CMASK
  #define CMASK(P0,P1,t) do{}while(0)
  for(;t+5<NT;t+=2){
    STEP(pB0,pB1,pA0,pA1,t,true,true,true);     WAIT_BAR(2); RESC(); ROT();
    STEP(pA0,pA1,pB0,pB1,t+1,true,true,true);   WAIT_BAR(2); RESC(); ROT();
  }
  #undef CMASK
  #define CMASK(P0,P1,t) do{int jb_=(t)-(NT-4); if(jb_>=0)cmask(P0,P1,jb_,qrel,hi);}while(0)
  #define ENDW(tt) do{ if((tt)+3<NT){WAIT_BAR(2);} else if((tt)+2<NT){WAIT_BAR(1);} else {WAIT_BAR(0);} }while(0)
  for(;t+1<NT;t+=2){
    STEP(pB0,pB1,pA0,pA1,t,(t+3<NT),(t+1<NT),(t+1<NT));       ENDW(t);   RESC(); ROT();
    STEP(pA0,pA1,pB0,pB1,t+1,(t+4<NT),(t+2<NT),(t+2<NT));     ENDW(t+1); RESC(); ROT();
  }
  STEP(pB0,pB1,pA0,pA1,NT-1,false,false,false); RESC();
  { float sacc=pB0[0]+pB0[1]; _Pragma("unroll") for(int r=2;r<16;++r)sacc+=pB0[r]; _Pragma("unroll") for(int r=0;r<16;++r)sacc+=pB1[r]; l_reg+=sacc;
    pw0=(u32x4){PKW(pB0,0),PKW(pB0,2),PKW(pB0,4),PKW(pB0,6)};pw1=(u32x4){PKW(pB0,8),PKW(pB0,10),PKW(pB0,12),PKW(pB0,14)};pw2=(u32x4){PKW(pB1,0),PKW(pB1,2),PKW(pB1,4),PKW(pB1,6)};pw3=(u32x4){PKW(pB1,8),PKW(pB1,10),PKW(pB1,12),PKW(pB1,14)};
    SBAR(); pv(o,vb0+sl_cur,PAF(0),PAF(1),PAF(2),PAF(3)); }
  #undef PKW
  #undef PAF
  #undef VFR
  #undef PIN
  #undef MX3
  #undef GAPA
  #undef GAPB
  #undef EX
  #undef VRD
  #undef KRD
  #undef STEP
  #undef ENDW
  {auto rr=__builtin_amdgcn_permlane32_swap(__float_as_uint(l_reg),__float_as_uint(l_reg),false,false);l_reg=__uint_as_float(rr[0])+__uint_as_float(rr[1]);}
  if(hi==0)wsf[32+r32]=l_reg;asm volatile("s_waitcnt lgkmcnt(0)":::"memory");
  float rli[16];
  #pragma unroll
  for(int r=0;r<16;++r)rli[r]=__builtin_amdgcn_rcpf(wsf[32+crow(r,hi)]);
  bf16*Ow=O+(rowbase+q0+wid*QBLK)*DM+vc;
  { bf16*stg=(bf16*)(shm+LDS_OST)+wid*2048;
    #pragma unroll
    for(int r=0;r<16;++r){const int orow=crow(r,hi);
      #pragma unroll
      for(int d0=0;d0<2;++d0)stg[orow*64+d0*32+r32]=__float2bfloat16(o[d0][r]*rli[r]);}
    asm volatile("s_waitcnt lgkmcnt(0)":::"memory");
    #pragma unroll
    for(int i=0;i<4;++i){const int row=i*8+(lane>>3),ch=lane&7; const u32x4 v=*(const u32x4*)(stg+row*64+ch*8); ATTN_STORE16(Ow+(long)row*DM+ch*8,v);} }
  asm volatile("s_waitcnt lgkmcnt(0)\n\ts_barrier":::"memory");
  #undef DMA_K
  #undef DMA_V
  #undef CMASK
  #undef START
  #undef RESC
  #undef ROT
}
constexpr int ATTN_LDS_BYTES=LDS_BYTES;
struct AttnTensors { const bf16* Q; const bf16* K; const bf16* V; bf16* O0; bf16* O1; };
struct AttnUnit { int bvh; int qb; };
struct DiffOrder {
  int vcu, G, blk;
  __device__ __forceinline__ explicit DiffOrder(int grid,int block):vcu((grid%8==0)?(block%8)*(grid/8)+block/8:block),G(grid),blk(block){}
  __device__ __forceinline__ bool next(int i,AttnUnit&u)const{
#ifdef ATTN_PAIR
    if(G==256){ if(i>=16)return false; const int r=i>>1,ii=i&1,w=vcu&15,grp=vcu>>4; u.bvh=(r>>1)*32+(grp>>1)*4+(r&1)*2+(grp&1); u.qb=ii?31-w:w; return true; }
#else
    if(G==256){ if(i>=16)return false; const int g=i>>2,ii=i&3,s=vcu&7; u.bvh=(vcu>>3)+32*g; u.qb=(ii==0)?s:(ii==1)?15-s:(ii==2)?16+s:31-s; return true; }
#endif
    const int L=i*G+blk; if(L>=4096)return false; u.qb=31-(L>>7); u.bvh=L&127; return true; }
};
template<int THRL,bool DOMAX> __device__ __forceinline__ void attn_phase(char*lds,const AttnTensors&T,const DiffOrder&S){
  AttnUnit u;
  for(int i=0;S.next(i,u);++i){ const int b=u.bvh>>5,vh=u.bvh&31,h=vh>>2,c=(vh>>1)&1,half=vh&1;
    attn_unit<THRL,DOMAX>(b,(2*h+c)*64,h*128+half*64,u.qb,T.Q,T.K,T.V,c?T.O1:T.O0,lds); }
}
#undef SBAR
#undef WAIT_BAR
}
namespace cg = cooperative_groups;
#define LAS __attribute__((address_space(3)))
typedef unsigned short bf16;
typedef unsigned v4u __attribute__((ext_vector_type(4)));
typedef unsigned v2u __attribute__((ext_vector_type(2)));
typedef float f32x4 __attribute__((ext_vector_type(4)));
typedef short bf16x8 __attribute__((ext_vector_type(8)));

constexpr int M_ROWS = 32768, DM = 1024, FF = 2816;
constexpr size_t MiB = 1u << 20;
constexpr size_t WS_MOD = 0;
constexpr size_t WS_BIAS = 1 * MiB;
constexpr size_t WS_SSQ = 3 * MiB;
constexpr size_t WS_ROPE = 5 * MiB;
constexpr size_t WS_WI = 8 * MiB;
constexpr size_t WS_WO = 96 * MiB;
constexpr size_t WS_AIN = 140 * MiB;
constexpr size_t WS_AOUT = 156 * MiB;
constexpr size_t WS_BIN = 160 * MiB;
constexpr size_t WS_BOUT = 166 * MiB;
constexpr size_t WS_CIN = 168 * MiB;
constexpr size_t WS_COUT = 174 * MiB;
constexpr size_t WS_XG = 176 * MiB;
constexpr size_t WS_SCR = 240 * MiB;
constexpr size_t WS_SSQP = 690 * MiB;
constexpr size_t WS_END = 694 * MiB;
constexpr size_t ACT = 64 * MiB;

__device__ __forceinline__ float bf_lo(unsigned u) { return __uint_as_float(u << 16); }
__device__ __forceinline__ float bf_hi(unsigned u) { return __uint_as_float(u & 0xffff0000u); }
__device__ __forceinline__ float bf2f(bf16 v) { return __uint_as_float((unsigned)v << 16); }
__device__ __forceinline__ unsigned pk2(float lo, float hi) { return pg8::cvt_pk_bf16(lo, hi); }
__device__ __forceinline__ bf16 f2bf(float f) { return (bf16)(pk2(f, 0.f) & 0xffffu); }
__device__ __forceinline__ float wave_sum(float v) {
#pragma unroll
    for (int o = 1; o < 64; o <<= 1) v += __shfl_xor(v, o);
    return v;
}
#define LDS_WAIT() asm volatile("s_waitcnt lgkmcnt(0)" ::: "memory")

__device__ __forceinline__ void tr_item(const float* W, int K, int Nsrc, bf16* WT, int k0, int n0dst, int n0src, LAS float* scr, int lane) {
    float wv[32];
#pragma unroll
    for (int i = 0; i < 32; ++i) wv[i] = __builtin_nontemporal_load(W + (size_t)(k0 + 2 * i + (lane >> 5)) * Nsrc + n0src + (lane & 31));
#pragma unroll
    for (int i = 0; i < 32; ++i) scr[(2 * i + (lane >> 5)) * 33 + (lane & 31)] = wv[i];
    LDS_WAIT(); asm volatile("" ::: "memory");
    const int c = lane & 7;
#pragma unroll
    for (int j = 0; j < 4; ++j) { const int n = (lane >> 3) + 8 * j; const LAS float* s = scr + (8 * c) * 33 + n;
        v4u o; o.x = pk2(s[0 * 33], s[1 * 33]); o.y = pk2(s[2 * 33], s[3 * 33]); o.z = pk2(s[4 * 33], s[5 * 33]); o.w = pk2(s[6 * 33], s[7 * 33]);
        *(v4u*)(WT + (size_t)(n0dst + n) * K + k0 + 8 * c) = o; }
    LDS_WAIT(); asm volatile("" ::: "memory");
}

__device__ __forceinline__ void hgrn_local(LAS unsigned char* L, const float* LOGF, const bf16* V, bf16* SLOC, float* DEC, int blk, int G, int tid) {
    LAS float* TOT = (LAS float*)L;
    LAS bf16* KT = (LAS bf16*)(L + 2048);
    LAS bf16* VT = (LAS bf16*)(L + 2048 + 18432);
    const int k = tid & 127, tq = tid >> 7, lane = tid & 63, wave = tid >> 6, fr = lane & 15, fq = lane >> 4;
    float lf[16]; v4u va, vb;
#define HL_LOAD(it_) do { const int h_ = (it_) & 7; const size_t r0_ = (size_t)((it_) >> 3) * 64; const float* lp_ = LOGF + (r0_ + tq * 16) * 1024 + h_ * 128 + k; \
        _Pragma("unroll") for (int i = 0; i < 16; ++i) lf[i] = lp_[(size_t)i * 1024]; \
        const bf16* vp_ = V + (r0_ + lane) * 1024 + h_ * 128 + wave * 16; va = *(const v4u*)vp_; vb = *(const v4u*)(vp_ + 8); } while (0)
    if (blk < 4096) HL_LOAD(blk);
    for (int item = blk; item < 4096; item += G) {
        float cs[16]; float run = 0.f; float ex[16];
#pragma unroll
        for (int i = 0; i < 16; ++i) { run += lf[i]; cs[i] = run; ex[i] = 1.0f - __expf(lf[i]); }
        TOT[tq * 128 + k] = run;
        { const unsigned vv[8] = {va.x, va.y, va.z, va.w, vb.x, vb.y, vb.z, vb.w};
#pragma unroll
          for (int e = 0; e < 8; ++e) { VT[(wave * 16 + 2 * e) * 72 + lane] = (bf16)(vv[e] & 0xffffu); VT[(wave * 16 + 2 * e + 1) * 72 + lane] = (bf16)(vv[e] >> 16); } }
        __syncthreads();
        if (item + G < 4096) HL_LOAD(item + G);
        float off = 0.f, tot = 0.f;
#pragma unroll
        for (int q = 0; q < 4; ++q) { const float t = TOT[q * 128 + k]; off += (q < tq) ? t : 0.f; tot += t; }
        unsigned pk[8];
#pragma unroll
        for (int i = 0; i < 8; ++i) pk[i] = pk2(ex[2 * i] * __expf(tot - (off + cs[2 * i])), ex[2 * i + 1] * __expf(tot - (off + cs[2 * i + 1])));
        *(LAS v4u*)(KT + k * 72 + tq * 16) = (v4u){pk[0], pk[1], pk[2], pk[3]};
        *(LAS v4u*)(KT + k * 72 + tq * 16 + 8) = (v4u){pk[4], pk[5], pk[6], pk[7]};
        if (tq == 0) DEC[(size_t)item * 128 + k] = __expf(tot);
        __syncthreads();
        const bf16x8 a0 = *(const LAS bf16x8*)(KT + (16 * wave + fr) * 72 + 8 * fq), a1 = *(const LAS bf16x8*)(KT + (16 * wave + fr) * 72 + 32 + 8 * fq);
        bf16* sp = SLOC + (size_t)item * 16384 + 16 * wave + 4 * fq;
#pragma unroll
        for (int nt = 0; nt < 8; ++nt) {
            const bf16x8 b0 = *(const LAS bf16x8*)(VT + (16 * nt + fr) * 72 + 8 * fq), b1 = *(const LAS bf16x8*)(VT + (16 * nt + fr) * 72 + 32 + 8 * fq);
            f32x4 c = {0.f, 0.f, 0.f, 0.f};
            c = __builtin_amdgcn_mfma_f32_16x16x32_bf16(a0, b0, c, 0, 0, 0); c = __builtin_amdgcn_mfma_f32_16x16x32_bf16(a1, b1, c, 0, 0, 0);
            *(v2u*)(sp + (16 * nt + fr) * 128) = (v2u){pk2(c[0], c[1]), pk2(c[2], c[3])};
        }
        __syncthreads();
    }
#undef HL_LOAD
}

__device__ __forceinline__ void hgrn_scan(bf16* SLOC, const float* DEC, int blk, int G, int tid) {
    for (int e = blk * 512 + tid; e < 131072; e += G * 512) {
        const int bh = e >> 12, idx4 = e & 4095, dv = idx4 >> 5, dk4 = (idx4 & 31) * 4, b = bh >> 3, h = bh & 7;
        f32x4 s = {0.f, 0.f, 0.f, 0.f};
        v2u loc[8]; f32x4 d[8]; v2u locn[8]; f32x4 dn[8];
#define HS_LOAD(L_, D_, c0_) do { _Pragma("unroll") for (int i = 0; i < 8; ++i) { const size_t it_ = (size_t)(b * 128 + (c0_) + i) * 8 + h; L_[i] = *(const v2u*)(SLOC + it_ * 16384 + dv * 128 + dk4); D_[i] = *(const f32x4*)(DEC + it_ * 128 + dk4); } } while (0)
#define HS_STEP(L_, D_, c0_) do { _Pragma("unroll") for (int i = 0; i < 8; ++i) { const size_t it_ = (size_t)(b * 128 + (c0_) + i) * 8 + h; \
            *(v2u*)(SLOC + it_ * 16384 + dv * 128 + dk4) = (v2u){pk2(s[0], s[1]), pk2(s[2], s[3])}; \
            const f32x4 lv = {bf_lo(L_[i].x), bf_hi(L_[i].x), bf_lo(L_[i].y), bf_hi(L_[i].y)}; s = D_[i] * s + lv; } } while (0)
        HS_LOAD(loc, d, 0);
        for (int c0 = 0; c0 < 128; c0 += 16) {
            HS_LOAD(locn, dn, c0 + 8);
            HS_STEP(loc, d, c0);
            if (c0 + 16 < 128) HS_LOAD(loc, d, c0 + 16);
            HS_STEP(locn, dn, c0 + 8);
        }
#undef HS_LOAD
#undef HS_STEP
    }
}

__device__ __forceinline__ void hgrn_out(LAS unsigned char* L, const float* LOGF, bf16* QA, const bf16* V, const bf16* Gt, const bf16* SLOC, const float* onorm, int blk, int G, int tid) {
    LAS float* TOT = (LAS float*)L;
    LAS bf16* QH = (LAS bf16*)(L + 2048);
    LAS bf16* QT = (LAS bf16*)(L + 19456);
    LAS bf16* KL = (LAS bf16*)(L + 36864);
    LAS bf16* VT = (LAS bf16*)(L + 54272);
    LAS bf16* ATT = (LAS bf16*)(L + 72704);
    LAS float* OB = (LAS float*)(L + 81920);
    const int k = tid & 127, tq = tid >> 7, lane = tid & 63, wave = tid >> 6, fr = lane & 15, fq = lane >> 4;
    const int mt = wave >> 1, t_n = tid >> 3, cg8 = tid & 7;
    float lf[16]; unsigned short qraw[16]; v4u va, vb;
#define HO_LOAD(it_) do { const int h_ = (it_) & 7; const size_t r0_ = (size_t)((it_) >> 3) * 64; const float* lp_ = LOGF + (r0_ + tq * 16) * 1024 + h_ * 128 + k; const bf16* qp_ = QA + (r0_ + tq * 16) * 1024 + h_ * 128 + k; \
        _Pragma("unroll") for (int i = 0; i < 16; ++i) { lf[i] = lp_[(size_t)i * 1024]; qraw[i] = qp_[(size_t)i * 1024]; } \
        const bf16* vp_ = V + (r0_ + lane) * 1024 + h_ * 128 + wave * 16; va = *(const v4u*)vp_; vb = *(const v4u*)(vp_ + 8); } while (0)
    if (blk < 4096) HO_LOAD(blk);
    for (int item = blk; item < 4096; item += G) {
        const int h = item & 7; const size_t row0 = (size_t)(item >> 3) * 64;
        bf16x8 sfrag[4][4];
#pragma unroll
        for (int q = 0; q < 4; ++q) { const bf16* sp = SLOC + (size_t)item * 16384 + (16 * ((wave & 1) * 4 + q) + fr) * 128 + 8 * fq;
#pragma unroll
            for (int kk = 0; kk < 4; ++kk) sfrag[q][kk] = *(const bf16x8*)(sp + 32 * kk); }
        const size_t goff = (row0 + t_n) * 1024 + h * 128 + cg8 * 16;
        const v4u g0 = *(const v4u*)(Gt + goff), g1 = *(const v4u*)(Gt + goff + 8);
        float cs[16], qv[16], kx[16]; float run = 0.f;
#pragma unroll
        for (int i = 0; i < 16; ++i) { run += lf[i]; cs[i] = run; qv[i] = bf2f(qraw[i]); kx[i] = 1.0f - __expf(lf[i]); }
        TOT[tq * 128 + k] = run;
        { const unsigned vv[8] = {va.x, va.y, va.z, va.w, vb.x, vb.y, vb.z, vb.w};
#pragma unroll
          for (int e = 0; e < 8; ++e) { VT[(wave * 16 + 2 * e) * 72 + lane] = (bf16)(vv[e] & 0xffffu); VT[(wave * 16 + 2 * e + 1) * 72 + lane] = (bf16)(vv[e] >> 16); } }
        __syncthreads();
        float off = 0.f;
#pragma unroll
        for (int q = 0; q < 4; ++q) { const float t = TOT[q * 128 + k]; off += (q < tq) ? t : 0.f; }
        const float mref = TOT[k] + TOT[128 + k];
#pragma unroll
        for (int i = 0; i < 16; ++i) { const float bc = off + cs[i]; const int o = (tq * 16 + i) * 136 + k;
            QH[o] = f2bf(qv[i] * __expf(bc)); QT[o] = f2bf(qv[i] * __expf(fminf(bc - mref, 80.f))); KL[o] = f2bf(kx[i] * __expf(fminf(mref - bc, 80.f))); }
        __syncthreads();
        if (item + G < 4096) HO_LOAD(item + G);
        {
            bf16x8 a[4];
#pragma unroll
            for (int kk = 0; kk < 4; ++kk) a[kk] = *(const LAS bf16x8*)(QT + (16 * mt + fr) * 136 + 32 * kk + 8 * fq);
#pragma unroll
            for (int q = 0; q < 2; ++q) { const int nt = (wave & 1) * 2 + q; f32x4 c = {0.f, 0.f, 0.f, 0.f};
#pragma unroll
                for (int kk = 0; kk < 4; ++kk) { const bf16x8 bb = *(const LAS bf16x8*)(KL + (16 * nt + fr) * 136 + 32 * kk + 8 * fq); c = __builtin_amdgcn_mfma_f32_16x16x32_bf16(a[kk], bb, c, 0, 0, 0); }
#pragma unroll
                for (int r = 0; r < 4; ++r) { const int t = 16 * mt + 4 * fq + r, s = 16 * nt + fr; ATT[t * 72 + s] = (s <= t) ? f2bf(c[r]) : (bf16)0; } }
        }
        __syncthreads();
        {
            bf16x8 aA[2], aQ[4];
#pragma unroll
            for (int kk = 0; kk < 2; ++kk) aA[kk] = *(const LAS bf16x8*)(ATT + (16 * mt + fr) * 72 + 32 * kk + 8 * fq);
#pragma unroll
            for (int kk = 0; kk < 4; ++kk) aQ[kk] = *(const LAS bf16x8*)(QH + (16 * mt + fr) * 136 + 32 * kk + 8 * fq);
#pragma unroll
            for (int q = 0; q < 4; ++q) { const int nt = (wave & 1) * 4 + q; f32x4 c = {0.f, 0.f, 0.f, 0.f};
#pragma unroll
                for (int kk = 0; kk < 2; ++kk) { const bf16x8 bb = *(const LAS bf16x8*)(VT + (16 * nt + fr) * 72 + 32 * kk + 8 * fq); c = __builtin_amdgcn_mfma_f32_16x16x32_bf16(aA[kk], bb, c, 0, 0, 0); }
#pragma unroll
                for (int kk = 0; kk < 4; ++kk) c = __builtin_amdgcn_mfma_f32_16x16x32_bf16(aQ[kk], sfrag[q][kk], c, 0, 0, 0);
#pragma unroll
                for (int r = 0; r < 4; ++r) OB[(16 * mt + 4 * fq + r) * 132 + 16 * nt + fr] = c[r]; }
        }
        __syncthreads();
        {
            f32x4 o[4]; float ss = 0.f;
#pragma unroll
            for (int i = 0; i < 4; ++i) { o[i] = *(const LAS f32x4*)(OB + t_n * 132 + cg8 * 16 + 4 * i); ss += (o[i][0] * o[i][0] + o[i][1] * o[i][1]) + (o[i][2] * o[i][2] + o[i][3] * o[i][3]); }
            ss += __shfl_xor(ss, 1); ss += __shfl_xor(ss, 2); ss += __shfl_xor(ss, 4);
            const float rs = __builtin_amdgcn_rsqf(ss * (1.0f / 128.0f) + 1e-6f);
            const unsigned gg[8] = {g0.x, g0.y, g0.z, g0.w, g1.x, g1.y, g1.z, g1.w};
            unsigned w[8];
#pragma unroll
            for (int i = 0; i < 4; ++i) { const f32x4 og = *(const f32x4*)(onorm + cg8 * 16 + 4 * i);
                w[2 * i] = pk2(o[i][0] * rs * og[0] * bf_lo(gg[2 * i]), o[i][1] * rs * og[1] * bf_hi(gg[2 * i]));
                w[2 * i + 1] = pk2(o[i][2] * rs * og[2] * bf_lo(gg[2 * i + 1]), o[i][3] * rs * og[3] * bf_hi(gg[2 * i + 1])); }
            *(v4u*)(QA + goff) = (v4u){w[0], w[1], w[2], w[3]}; *(v4u*)(QA + goff + 8) = (v4u){w[4], w[5], w[6], w[7]};
        }
        __syncthreads();
    }
#undef HO_LOAD
}

#define XB_TMO      128
#define XB_XCNT(j)  (256  + 64 * (j))
#define XB_XSUB(j)  (1280 + 64 * (j))
#define XB_XGEN(j)  (2304 + 64 * (j))
#define XB_TOP      3328
#define XB_TOPGEN   3392
#define XCD_BAR_WORDS 3456
#define XB_SPIN_CAP (1u << 18)

__device__ __forceinline__ unsigned xb_ld(unsigned* p)              { return __hip_atomic_load(p, __ATOMIC_RELAXED, __HIP_MEMORY_SCOPE_AGENT); }
__device__ __forceinline__ unsigned xb_add(unsigned* p, unsigned v) { return __hip_atomic_fetch_add(p, v, __ATOMIC_RELAXED, __HIP_MEMORY_SCOPE_AGENT); }
__device__ __forceinline__ unsigned xb_xcc_id() { return (unsigned)__builtin_amdgcn_s_getreg((3 << 11) | 20) & 0xFu; }
#define XB_SPIN(cond, bar) do { unsigned _sp = 0; while (cond) { __builtin_amdgcn_s_sleep(1); \
    if ((++_sp & 255u) == 0u) { if (xb_ld(&(bar)[XB_TMO])) break; if (_sp > XB_SPIN_CAP) { atomicAdd(&(bar)[XB_TMO], 1u); break; } } } } while (0)

struct XcdBarrier {
    unsigned* bar; unsigned x;
    volatile LAS unsigned* st;
};

__device__ __forceinline__ XcdBarrier xcd_barrier_post(unsigned* bar, volatile LAS unsigned* st) {
    XcdBarrier b; b.bar = bar; b.x = xb_xcc_id(); b.st = st;
    if (threadIdx.x == 0) (void)xb_add(&bar[XB_XCNT(b.x)], 1u);
    return b;
}
__device__ __forceinline__ void xcd_barrier_complete(unsigned* bar, unsigned x, unsigned& nloc, unsigned& nx) {
    const unsigned G = gridDim.x * gridDim.y * gridDim.z;
    unsigned sum, cnt, mine, sp = 0u;
    for (;;) {
        sum = 0u; cnt = 0u; mine = 0u;
#pragma unroll
        for (unsigned j = 0; j < 16; ++j) { const unsigned c = xb_ld(&bar[XB_XCNT(j)]); sum += c; cnt += (c > 0u) ? 1u : 0u; mine = (j == x) ? c : mine; }
        if (sum == G) break;
        __builtin_amdgcn_s_sleep(1);
        if ((++sp & 255u) == 0u) { if (xb_ld(&bar[XB_TMO])) break; if (sp > XB_SPIN_CAP) { atomicAdd(&bar[XB_TMO], 1u); break; } }
    }
    nloc = mine > 0u ? mine : 1u; nx = cnt > 0u ? cnt : 1u;
}

__device__ __forceinline__ void xcd_barrier(const XcdBarrier& b) {
    asm volatile("s_waitcnt vmcnt(0)" ::: "memory");
    __syncthreads();
    if (threadIdx.x == 0) {
        unsigned* bar = b.bar;
        __builtin_amdgcn_s_waitcnt(0);
        unsigned nloc = b.st[0], nx = b.st[1];
        if (nloc == 0u) { xcd_barrier_complete(bar, b.x, nloc, nx); b.st[0] = nloc; b.st[1] = nx; }
        const unsigned old = xb_add(&bar[XB_XSUB(b.x)], 1u);
        const unsigned gen = old / nloc;
        if (old + 1u == (gen + 1u) * nloc) {
            __builtin_amdgcn_fence(__ATOMIC_RELEASE, "agent");
            asm volatile("s_waitcnt vmcnt(0)" ::: "memory");
            const unsigned og = xb_add(&bar[XB_TOP], 1u);
            const unsigned tg = og / nx;
            if (og + 1u == (tg + 1u) * nx) xb_add(&bar[XB_TOPGEN], 1u);
            else XB_SPIN(xb_ld(&bar[XB_TOPGEN]) == tg, bar);
            __builtin_amdgcn_fence(__ATOMIC_ACQUIRE, "agent");
            xb_add(&bar[XB_XGEN(b.x)], 1u);
            asm volatile("s_waitcnt vmcnt(0)" ::: "memory");
        } else {
            XB_SPIN(xb_ld(&bar[XB_XGEN(b.x)]) == gen, bar);
            __builtin_amdgcn_fence(__ATOMIC_ACQUIRE, "agent");
            asm volatile("s_waitcnt vmcnt(0)" ::: "memory");
        }
    }
    __syncthreads();
}

constexpr size_t WS_BAR = 7 * MiB;
struct Args { const void* in[20]; float* out; unsigned char* ws; };
constexpr int MISC_OFF = 131072, LDS_BYTES = 131072 + 256 + 11 * 512 * 4;

__global__ void __launch_bounds__(512) mega_fwd(Args a) {
    extern __shared__ __attribute__((aligned(16))) unsigned char lds[];
    cg::grid_group grid = cg::this_grid();
    LAS unsigned char* L = (LAS unsigned char*)lds;
    const int G = gridDim.x, blk = blockIdx.x;
    if (threadIdx.x < 64) ((LAS unsigned*)(L + MISC_OFF))[threadIdx.x] = 0u;
    __syncthreads();
#define TIDS() const int tid = opaque_tid(), lane = tid & 63, wave = __builtin_amdgcn_readfirstlane(tid >> 6), gw = blk * 8 + wave, NGW = G * 8; (void)lane; (void)gw; (void)NGW
    typedef __attribute__((address_space(4))) const Args CArgs;
    const CArgs* const ap0 = (const CArgs*)__builtin_amdgcn_kernarg_segment_ptr();
#define ARGS() ({ const CArgs* p_ = ap0; asm volatile("" : "+s"(p_)); p_; })
#define CG_SYNC() do { asm volatile("s_waitcnt vmcnt(0) lgkmcnt(0)" ::: "memory"); grid.sync(); __builtin_amdgcn_fence(__ATOMIC_ACQUIRE, "agent"); asm volatile("s_waitcnt vmcnt(0)" ::: "memory"); } while (0)
#define XBAR_MAKE() XcdBarrier b_; b_.bar = (unsigned*)(ARGS()->ws + WS_BAR); b_.x = xb_xcc_id(); b_.st = (volatile LAS unsigned*)(L + MISC_OFF)
#ifdef DUP_SYNC
#define GRID_SYNC() do { XBAR_MAKE(); xcd_barrier(b_); xcd_barrier(b_); } while (0)
#else
#define GRID_SYNC() do { XBAR_MAKE(); xcd_barrier(b_); } while (0)
#endif
#define IN_F(k) ((const float*)ap->in[k])
#define WSP(off) (ap->ws + (off))
#ifndef P0REP
#define P0REP 1
#endif
    for (int rep_ = 0; rep_ < P0REP; ++rep_)
    {
        const CArgs* ap = ARGS(); TIDS();
        const float* c_in = IN_F(1); const float* ada_w = IN_F(3); const float* ada_b = IN_F(4); float* MOD = (float*)WSP(WS_MOD);
        LAS float* CA = (LAS float*)L; LAS float* PS = (LAS float*)(L + 16384);
        for (int i = tid; i < 4096; i += 512) { const float v = c_in[i]; CA[i] = pg8::silu_f(v); }
        if (blk == 0) for (int i = tid; i < XCD_BAR_WORDS; i += 512) ((unsigned*)WSP(WS_BAR))[i] = 0u;
        __syncthreads();
        for (int it = blk; it < 576; it += G) {
            const int l = it / 144, n0 = (it % 144) * 64;
            const float* wp = ada_w + ((size_t)l * 1024 + wave * 128) * 9216 + n0 + lane;
            float s0 = 0.f, s1 = 0.f, s2 = 0.f, s3 = 0.f;
#pragma unroll 16
            for (int kk = 0; kk < 128; ++kk) { const float w = __builtin_nontemporal_load(wp + (size_t)kk * 9216); const int k = wave * 128 + kk;
                s0 += CA[k] * w; s1 += CA[1024 + k] * w; s2 += CA[2048 + k] * w; s3 += CA[3072 + k] * w; }
            PS[(wave * 4 + 0) * 64 + lane] = s0; PS[(wave * 4 + 1) * 64 + lane] = s1; PS[(wave * 4 + 2) * 64 + lane] = s2; PS[(wave * 4 + 3) * 64 + lane] = s3;
            __syncthreads();
            if (tid < 256) { const int b = tid >> 6, n = tid & 63; float s = ada_b[l * 9216 + n0 + n];
#pragma unroll
                for (int w = 0; w < 8; ++w) s += PS[(w * 4 + b) * 64 + n];
                MOD[(size_t)(l * 4 + b) * 9216 + n0 + n] = s; }
            __syncthreads();
        }
        const int* positions = (const int*)ap->in[2]; float* ROPE = (float*)WSP(WS_ROPE);
        for (int e = blk * 512 + tid; e < 32768 * 8; e += G * 512) {
            const int row = e >> 3, j = e & 7;
            const float invf = j == 0 ? 1.0f : j == 1 ? 0.19392274474868576f : j == 2 ? 0.03760603093086393f : j == 3 ? 0.007292664737217109f : j == 4 ? 0.001414213562373095f : j == 5 ? 0.0002742481756762073f : j == 6 ? 5.318295896944988e-05f : 1.031338537721246e-05f;
            const float ang = (float)positions[row] * invf;
            const double rev = (double)ang * 0.15915494309189535; const float fr_ = (float)(rev - __builtin_rint(rev));
            ROPE[(size_t)row * 16 + j] = __builtin_amdgcn_cosf(fr_); ROPE[(size_t)row * 16 + 8 + j] = __builtin_amdgcn_sinf(fr_);
        }
        LAS float* scr = (LAS float*)(L + wave * 16384);
        for (int it0 = gw; it0 < 43008; it0 += NGW) {
            int it = it0; ap = ARGS();
            const float* ffn_wi = IN_F(6); const float* ffn_wo = IN_F(7); const float* a_w_in = IN_F(8); const float* a_w_out = IN_F(9); const float* b_w_in = IN_F(12); const float* b_w_out = IN_F(13); const float* c_w_in = IN_F(17); const float* c_w_out = IN_F(19);
            bf16* WI = (bf16*)WSP(WS_WI); bf16* WO = (bf16*)WSP(WS_WO); bf16* AIN = (bf16*)WSP(WS_AIN); bf16* AOUT = (bf16*)WSP(WS_AOUT); bf16* BIN = (bf16*)WSP(WS_BIN); bf16* BOUT = (bf16*)WSP(WS_BOUT); bf16* CIN = (bf16*)WSP(WS_CIN); bf16* COUT = (bf16*)WSP(WS_COUT);
            if (it < 22528) { const int mat = it / 2816, r = it % 2816, kb = r / 176, n0 = (r % 176) * 32; const int src = ((n0 & 255) >> 7) * 2816 + (n0 >> 8) * 128 + (n0 & 127);
                tr_item(ffn_wi + (size_t)mat * 1024 * 5632, 1024, 5632, WI + (size_t)mat * 5632 * 1024, kb * 64, n0, src, scr, lane); continue; } it -= 22528;
            if (it < 11264) { const int mat = it / 1408, r = it % 1408, kb = r / 32, n0 = (r % 32) * 32;
                tr_item(ffn_wo + (size_t)mat * 2816 * 1024, 2816, 1024, WO + (size_t)mat * 1024 * 2816, kb * 64, n0, n0, scr, lane); continue; } it -= 11264;
            if (it < 4096) { const int mat = it / 2048, r = it % 2048, kb = r / 128, n0 = (r % 128) * 32;
                tr_item(a_w_in + (size_t)mat * 1024 * 4096, 1024, 4096, AIN + (size_t)mat * 4096 * 1024, kb * 64, n0, n0, scr, lane); continue; } it -= 4096;
            if (it < 1024) { const int mat = it / 512, r = it % 512, kb = r / 32, n0 = (r % 32) * 32;
                tr_item(a_w_out + (size_t)mat * 1024 * 1024, 1024, 1024, AOUT + (size_t)mat * 1024 * 1024, kb * 64, n0, n0, scr, lane); continue; } it -= 1024;
            if (it < 1536) { const int kb = it / 96, n0 = (it % 96) * 32; const int src = n0 < 2048 ? (n0 >> 8) * 256 + ((n0 & 127) >> 5) * 64 + ((n0 & 255) >> 7) * 32 : n0;
                tr_item(b_w_in, 1024, 3072, BIN, kb * 64, n0, src, scr, lane); continue; } it -= 1536;
            if (it < 512) { const int kb = it / 32, n0 = (it % 32) * 32; tr_item(b_w_out, 1024, 1024, BOUT, kb * 64, n0, n0, scr, lane); continue; } it -= 512;
            if (it < 1536) { const int kb = it / 96, n0 = (it % 96) * 32; const int src = n0 < 2048 ? 1024 + ((n0 & 255) >> 7) * 1024 + (n0 >> 8) * 128 + (n0 & 127) : n0 - 2048;
                tr_item(c_w_in, 1024, 3072, CIN, kb * 64, n0, src, scr, lane); continue; } it -= 1536;
            { const int kb = it / 32, n0 = (it % 32) * 32; tr_item(c_w_out, 1024, 1024, COUT, kb * 64, n0, n0, scr, lane); }
        }
        __syncthreads();
    }
    CG_SYNC();
    (void)xcd_barrier_post((unsigned*)(ARGS()->ws + WS_BAR), (volatile LAS unsigned*)(L + MISC_OFF));
    {
        const CArgs* ap = ARGS(); TIDS();
        const float* x_in = IN_F(0); const float* norm_g = IN_F(5); float* MOD = (float*)WSP(WS_MOD); float* BIAS = (float*)WSP(WS_BIAS); float* SSQ = (float*)WSP(WS_SSQP); bf16* XG = (bf16*)WSP(WS_XG);
        bf16* WI = (bf16*)WSP(WS_WI); bf16* AIN = (bf16*)WSP(WS_AIN); bf16* BIN = (bf16*)WSP(WS_BIN); bf16* CIN = (bf16*)WSP(WS_CIN);
        for (int slot = gw; slot < 12 * 88; slot += NGW) {
            const int sl = slot / 88, ng = slot % 88, l = sl / 3, j = sl % 3, kind = l % 3, idx = l / 3;
            const bf16* Wt; int N;
            if (j != 1) { Wt = WI + (size_t)(l * 2 + (j >> 1)) * 5632 * 1024; N = 5632; }
            else if (kind == 0) { Wt = AIN + (size_t)idx * 4096 * 1024; N = 4096; }
            else if (kind == 1) { Wt = BIN; N = 3072; }
            else { Wt = CIN; N = 3072; }
            if (ng * 64 >= N) continue;
            f32x4 sh[4][4];
#pragma unroll
            for (int b = 0; b < 4; ++b)
#pragma unroll
                for (int i = 0; i < 4; ++i) sh[b][i] = *(const f32x4*)(MOD + (size_t)(l * 4 + b) * 9216 + (j * 3) * 1024 + lane * 16 + 4 * i);
            float res0 = 0.f, res1 = 0.f, res2 = 0.f, res3 = 0.f;
            for (int nn = 0; nn < 64; ++nn) {
                const bf16* wr_ = Wt + (size_t)(ng * 64 + nn) * 1024 + lane * 16;
                const v4u w0 = *(const v4u*)wr_, w1 = *(const v4u*)(wr_ + 8);
                const unsigned ww[8] = {w0.x, w0.y, w0.z, w0.w, w1.x, w1.y, w1.z, w1.w};
                float d[4] = {0.f, 0.f, 0.f, 0.f};
#pragma unroll
                for (int i = 0; i < 4; ++i) { const float e0 = bf_lo(ww[2 * i]), e1 = bf_hi(ww[2 * i]), e2 = bf_lo(ww[2 * i + 1]), e3 = bf_hi(ww[2 * i + 1]);
#pragma unroll
                    for (int b = 0; b < 4; ++b) d[b] += (e0 * sh[b][i][0] + e1 * sh[b][i][1]) + (e2 * sh[b][i][2] + e3 * sh[b][i][3]); }
                const float t0 = wave_sum(d[0]), t1 = wave_sum(d[1]), t2 = wave_sum(d[2]), t3 = wave_sum(d[3]);
                if (lane == nn) { res0 = t0; res1 = t1; res2 = t2; res3 = t3; }
            }
            float* bp = BIAS + (size_t)sl * 4 * 5632 + ng * 64 + lane;
            bp[0] = res0; bp[5632] = res1; bp[2 * 5632] = res2; bp[3 * 5632] = res3;
        }
        for (int row = gw; row < M_ROWS; row += NGW) {
            const int b = row >> 13; const f32x4* xr = (const f32x4*)(x_in + (size_t)row * 1024) + lane;
            f32x4 v[4]; float s = 0.f;
#pragma unroll
            for (int jj = 0; jj < 4; ++jj) { v[jj] = __builtin_nontemporal_load(xr + 64 * jj); s += (v[jj][0] * v[jj][0] + v[jj][1] * v[jj][1]) + (v[jj][2] * v[jj][2] + v[jj][3] * v[jj][3]); }
            s = wave_sum(s); if (lane < 16) SSQ[(size_t)row * 16 + lane] = lane == 0 ? s : 0.f;
#pragma unroll
            for (int jj = 0; jj < 4; ++jj) { const int k = 256 * jj + 4 * lane; const f32x4 g = *(const f32x4*)(norm_g + k) * (*(const f32x4*)(MOD + (size_t)b * 9216 + 1024 + k) + 1.0f); const f32x4 y = v[jj] * g;
                *(v2u*)(XG + (size_t)row * 1024 + k) = (v2u){pk2(y[0], y[1]), pk2(y[2], y[3])}; }
        }
    }
    GRID_SYNC();

#ifndef PG8_ALIGN_EPI
#define PG8_ALIGN_EPI true
#endif
#ifndef PG8_SP2
#define PG8_SP2 true
#endif
#define GEMM_CALL(EpiT, E, Aptr, Btptr, N_, K_) do { const pg8::Gemm g_{(const pg8::bf16_t*)(Aptr), (const pg8::bf16_t*)(Btptr), M_ROWS, (N_), (K_)}; pg8::StaticOrder S_; S_.init(M_ROWS, (N_), G, blk); \
        pg8::gemm_phase<EpiT, pg8::StaticOrder, PG8_ALIGN_EPI, PG8_SP2>(L, g_, S_, E); } while (0)

#ifndef NSUB
#define NSUB 12
#endif
    for (int sl = 0; sl < NSUB; ++sl) {
        const int l = sl / 3, j = sl % 3, kind = l % 3, idx = l / 3;
        const CArgs* ap = ARGS();
        unsigned char* SCR = WSP(WS_SCR); bf16* XG = (bf16*)WSP(WS_XG);
        const float* ssq_cur = (const float*)WSP(WS_SSQP) + (size_t)(sl & 1) * 32768 * 16; const float* bias_cur = (const float*)WSP(WS_BIAS) + (size_t)sl * 4 * 5632;
        const bf16* Amix; const bf16* Wout; int Kout;
        if (j != 1) {
            bf16* HID = (bf16*)SCR;
#ifdef DUP_SWIGLU
            for (int rep_ = 0; rep_ < 2; ++rep_) {
            { LAS float* el = (LAS float*)(L + pg8::EPI_LDS_OFF); { pg8::StaticOrder S0; S0.init(M_ROWS, 5632, G, blk); const int t0_ = opaque_tid(); pg8::stage_swiglu(el, S0, ssq_cur, bias_cur, __builtin_amdgcn_readfirstlane(t0_ >> 6), t0_ & 63); } __syncthreads();
              const pg8::EpiSwiGLU E{HID, el}; GEMM_CALL(pg8::EpiSwiGLU, E, XG, (const bf16*)WSP(WS_WI) + (size_t)(l * 2 + (j >> 1)) * 5632 * 1024, 5632, rep_ == 0 ? DUP_K : 1024); }
            GRID_SYNC(); ap = ARGS(); }
#else
            { LAS float* el = (LAS float*)(L + pg8::EPI_LDS_OFF);
              { pg8::StaticOrder S0; S0.init(M_ROWS, 5632, G, blk); const int t0_ = opaque_tid(); pg8::stage_swiglu(el, S0, ssq_cur, bias_cur, __builtin_amdgcn_readfirstlane(t0_ >> 6), t0_ & 63); }
              __syncthreads();
              const pg8::EpiSwiGLU E{HID, el}; GEMM_CALL(pg8::EpiSwiGLU, E, XG, (const bf16*)WSP(WS_WI) + (size_t)(l * 2 + (j >> 1)) * 5632 * 1024, 5632, 1024); }
            GRID_SYNC();
#endif
            ap = ARGS(); Amix = (const bf16*)WSP(WS_SCR); Wout = (const bf16*)WSP(WS_WO) + (size_t)(l * 2 + (j >> 1)) * 1024 * 2816; Kout = 2816;
        } else if (kind == 0) {
            bf16* Qb = (bf16*)SCR; bf16* Vb = (bf16*)(SCR + ACT); bf16* Gb = (bf16*)(SCR + 2 * ACT); float* LOGF = (float*)(SCR + 3 * ACT); bf16* SLOC = (bf16*)(SCR + 5 * ACT); float* DEC = (float*)(SCR + 7 * ACT);
            { const pg8::EpiHgrnIn E{Qb, LOGF, ssq_cur, bias_cur, IN_F(10), idx}; GEMM_CALL(pg8::EpiHgrnIn, E, XG, (const bf16*)WSP(WS_AIN) + (size_t)idx * 4096 * 1024, 4096, 1024); }
            GRID_SYNC();
#if !defined(NO_HGRN) && !defined(NO_HL)
            hgrn_local(L, LOGF, Vb, SLOC, DEC, blk, G, opaque_tid());
#endif
#ifdef DUP_HL
            hgrn_local(L, LOGF, Vb, SLOC, DEC, blk, G, opaque_tid());
#endif
            GRID_SYNC();
#if !defined(NO_HGRN) && !defined(NO_HS)
            hgrn_scan(SLOC, DEC, blk, G, opaque_tid());
#endif
            GRID_SYNC();
#if !defined(NO_HGRN) && !defined(NO_HO)
            hgrn_out(L, LOGF, Qb, Vb, Gb, SLOC, IN_F(11) + idx * 128, blk, G, opaque_tid());
#endif
            GRID_SYNC();
            ap = ARGS(); Amix = (const bf16*)WSP(WS_SCR); Wout = (const bf16*)WSP(WS_AOUT) + (size_t)idx * 1024 * 1024; Kout = 1024;
        } else if (kind == 1) {
            bf16* Qb = (bf16*)SCR; bf16* Kb = (bf16*)(SCR + ACT); bf16* Vb = (bf16*)(SCR + 2 * ACT); bf16* O0 = (bf16*)(SCR + 3 * ACT); bf16* O1 = (bf16*)(SCR + 4 * ACT); bf16* Am = (bf16*)(SCR + 5 * ACT);
            { const pg8::EpiAttnIn E{Qb, ssq_cur, bias_cur, IN_F(14), (const float*)WSP(WS_ROPE)}; GEMM_CALL(pg8::EpiAttnIn, E, XG, (const bf16*)WSP(WS_BIN), 3072, 1024); }
            GRID_SYNC();
            { const attn_body::AttnTensors AT{(const attn_body::bf16*)Qb, (const attn_body::bf16*)Kb, (const attn_body::bf16*)Vb, (attn_body::bf16*)O0, (attn_body::bf16*)O1};
              const attn_body::DiffOrder S((int)G, (int)blk);
              float gq = 0.f, gk = 0.f; { const float* qkg = IN_F(14); const int ln = opaque_tid() & 63; gq = fabsf(qkg[ln]); gk = fabsf(qkg[64 + ln]);
#pragma unroll
                for (int o = 1; o < 64; o <<= 1) { gq = fmaxf(gq, __shfl_xor(gq, o)); gk = fmaxf(gk, __shfl_xor(gk, o)); } }
              const bool bounded = __builtin_amdgcn_readfirstlane(11.6f * gq * gk < 40.0f ? 1 : 0) != 0;
              if (bounded) attn_body::attn_phase<8, false>((char*)lds, AT, S);
              else attn_body::attn_phase<8, true>((char*)lds, AT, S);
            }
            GRID_SYNC();
            {   TIDS();
                const float lambda_init = 0.35550906759096934f; const float* b_lam = IN_F(15); const float* b_subln = IN_F(16);
                const float s1 = wave_sum(b_lam[lane] * b_lam[64 + lane]), s2 = wave_sum(b_lam[128 + lane] * b_lam[192 + lane]);
                const float lam = __expf(s1) - __expf(s2) + lambda_init;
                const int c0 = lane * 16;
                f32x4 sg[4];
#pragma unroll
                for (int i = 0; i < 4; ++i) sg[i] = *(const f32x4*)(b_subln + (c0 & 127) + 4 * i) * (1.0f - lambda_init);
                for (int row = gw; row < M_ROWS; row += NGW) {
                    const size_t off = (size_t)row * 1024 + c0;
                    const v4u p0 = *(const v4u*)(O0 + off), p1 = *(const v4u*)(O0 + off + 8), q0 = *(const v4u*)(O1 + off), q1 = *(const v4u*)(O1 + off + 8);
                    const unsigned pa[8] = {p0.x, p0.y, p0.z, p0.w, p1.x, p1.y, p1.z, p1.w}, qa[8] = {q0.x, q0.y, q0.z, q0.w, q1.x, q1.y, q1.z, q1.w};
                    float v[16]; float ss = 0.f;
#pragma unroll
                    for (int i = 0; i < 8; ++i) { v[2 * i] = bf_lo(pa[i]) - lam * bf_lo(qa[i]); v[2 * i + 1] = bf_hi(pa[i]) - lam * bf_hi(qa[i]); ss += v[2 * i] * v[2 * i] + v[2 * i + 1] * v[2 * i + 1]; }
                    ss += __shfl_xor(ss, 1); ss += __shfl_xor(ss, 2); ss += __shfl_xor(ss, 4);
                    const float rs = __builtin_amdgcn_rsqf(ss * (1.0f / 128.0f) + 1e-6f);
                    unsigned w[8];
#pragma unroll
                    for (int i = 0; i < 8; ++i) w[i] = pk2(v[2 * i] * rs * sg[i >> 1][(2 * i) & 3], v[2 * i + 1] * rs * sg[i >> 1][(2 * i + 1) & 3]);
                    *(v4u*)(Am + off) = (v4u){w[0], w[1], w[2], w[3]}; *(v4u*)(Am + off + 8) = (v4u){w[4], w[5], w[6], w[7]};
                }
            }
            GRID_SYNC();
            ap = ARGS(); Amix = (const bf16*)(WSP(WS_SCR) + 5 * ACT); Wout = (const bf16*)WSP(WS_BOUT); Kout = 1024;
        } else {
            bf16* BGb = (bf16*)SCR; bf16* U2 = (bf16*)(SCR + ACT); bf16* Am = (bf16*)(SCR + 2 * ACT);
            { const pg8::EpiConvIn E{BGb, U2, ssq_cur, bias_cur}; GEMM_CALL(pg8::EpiConvIn, E, XG, (const bf16*)WSP(WS_CIN), 3072, 1024); }
            GRID_SYNC();
#ifndef NO_CONVEL
            {   TIDS();
                const int c0 = lane * 16; const float* c_conv = IN_F(18);
                f32x4 w0[4], w1[4], w2[4];
#pragma unroll
                for (int i = 0; i < 4; ++i) { w0[i] = *(const f32x4*)(c_conv + c0 + 4 * i); w1[i] = *(const f32x4*)(c_conv + 1024 + c0 + 4 * i); w2[i] = *(const f32x4*)(c_conv + 2048 + c0 + 4 * i); }
#ifdef CONV_LOCAL
                for (int ri = 0; ri < 16; ++ri) { const int row = (blk & 7) * 4096 + (blk >> 3) * 8 + wave + 256 * ri;
#else
                for (int row = gw; row < M_ROWS; row += NGW) {
#endif
                    const int t = row & 8191; const size_t off = (size_t)row * 1024 + c0;
                    const v4u z = {0u, 0u, 0u, 0u};
                    const v4u a0 = *(const v4u*)(U2 + off), a1 = *(const v4u*)(U2 + off + 8);
#ifdef CONV_NONEIGH
                    const v4u b0 = z, b1 = z, d0 = z, d1 = z; (void)t;
#else
                    const v4u b0 = t >= 1 ? *(const v4u*)(U2 + off - 1024) : z, b1 = t >= 1 ? *(const v4u*)(U2 + off - 1024 + 8) : z;
                    const v4u d0 = t >= 2 ? *(const v4u*)(U2 + off - 2048) : z, d1 = t >= 2 ? *(const v4u*)(U2 + off - 2048 + 8) : z;
#endif
                    const v4u g0 = *(const v4u*)(BGb + off), g1 = *(const v4u*)(BGb + off + 8);
                    const unsigned ua[8] = {a0.x, a0.y, a0.z, a0.w, a1.x, a1.y, a1.z, a1.w}, ub[8] = {b0.x, b0.y, b0.z, b0.w, b1.x, b1.y, b1.z, b1.w}, ud[8] = {d0.x, d0.y, d0.z, d0.w, d1.x, d1.y, d1.z, d1.w}, ug[8] = {g0.x, g0.y, g0.z, g0.w, g1.x, g1.y, g1.z, g1.w};
                    unsigned w[8];
#pragma unroll
                    for (int i = 0; i < 8; ++i) { const int q = i >> 1, e = (2 * i) & 3;
                        const float y0 = w0[q][e] * bf_lo(ud[i]) + w1[q][e] * bf_lo(ub[i]) + w2[q][e] * bf_lo(ua[i]), y1 = w0[q][e + 1] * bf_hi(ud[i]) + w1[q][e + 1] * bf_hi(ub[i]) + w2[q][e + 1] * bf_hi(ua[i]);
#if defined(CONV_T1)
                        w[i] = ug[i]; (void)y0; (void)y1;
#elif defined(CONV_T2)
                        w[i] = ua[i]; (void)y0; (void)y1;
#elif defined(CONV_T3)
                        w[i] = ((const unsigned*)(XG + off))[i]; (void)y0; (void)y1;
#else
                        w[i] = pk2(bf_lo(ug[i]) * y0, bf_hi(ug[i]) * y1);
#endif
                    }
                    *(v4u*)(Am + off) = (v4u){w[0], w[1], w[2], w[3]}; *(v4u*)(Am + off + 8) = (v4u){w[4], w[5], w[6], w[7]};
                }
            }
#endif
            GRID_SYNC();
            ap = ARGS(); Amix = (const bf16*)(WSP(WS_SCR) + 2 * ACT); Wout = (const bf16*)WSP(WS_COUT); Kout = 1024;
        }
        {
            const bool has_next = sl < 11; const int sn = sl + 1, jn = sn % 3;
            float* out = ap->out; const float* x_in = IN_F(0); const float* norm_g = IN_F(5); float* MOD = (float*)WSP(WS_MOD); float* SSQ = (float*)WSP(WS_SSQP); bf16* XGn = (bf16*)WSP(WS_XG);
            const int snv = has_next ? sn : 0, lnv = snv / 3;
            const pg8::EpiRes E{x_in, out, XGn, SSQ + (size_t)(snv & 1) * 32768 * 16, MOD + (size_t)l * 36864 + (j * 3 + 2) * 1024,
                                norm_g + (size_t)sl * 1024, MOD + (size_t)l * 36864 + (j * 3 + 1) * 1024,
                                norm_g + (size_t)snv * 1024, MOD + (size_t)lnv * 36864 + (jn * 3 + 1) * 1024, j == 1 ? 1.0f : 0.5f, sl == 0 ? 0 : (has_next ? 1 : 2)};
            GEMM_CALL(pg8::EpiRes, E, Amix, Wout, 1024, Kout);
        }
        if (sl < NSUB - 1) GRID_SYNC();
    }
}

extern "C" void kernel_launch(void* const* d_in, const int* in_sizes, int n_in, void* d_out, int out_size, void* d_ws, size_t ws_size, hipStream_t stream) {
    static int grid = 0;
    if (grid == 0) {
        if (n_in != 20 || out_size != M_ROWS * DM || ws_size < WS_END) { fprintf(stderr, "kernel_launch: unexpected problem (n_in %d, out %d, ws %zu; need ws >= %zu)\n", n_in, out_size, ws_size, (size_t)WS_END); grid = -1; return; }
        int dev = 0, cus = 0, per_cu = 0;
        if (hipGetDevice(&dev) != hipSuccess || hipDeviceGetAttribute(&cus, hipDeviceAttributeMultiprocessorCount, dev) != hipSuccess) { grid = -1; return; }
        (void)hipFuncSetAttribute((const void*)mega_fwd, hipFuncAttributeMaxDynamicSharedMemorySize, LDS_BYTES);
        if (hipOccupancyMaxActiveBlocksPerMultiprocessor(&per_cu, (const void*)mega_fwd, 512, LDS_BYTES) != hipSuccess || per_cu < 1) { fprintf(stderr, "kernel_launch: occupancy query gave %d\n", per_cu); per_cu = 1; }
        (void)hipGetLastError();
        grid = cus * per_cu;
    }
    if (grid < 0) return;
    Args a{};
    for (int i = 0; i < 20; ++i) a.in[i] = d_in[i];
    a.out = (float*)d_out; a.ws = (unsigned char*)d_ws;
    void* args[] = {&a};
    const hipError_t e = hipLaunchCooperativeKernel((const void*)mega_fwd, dim3(grid), dim3(512), args, LDS_BYTES, stream);
    if (e != hipSuccess) fprintf(stderr, "kernel_launch: cooperative launch failed: %s (grid %d)\n", hipGetErrorString(e), grid);
}
```
